# Optimizing an MI355X kernel written in HIP

```python
import jax, jax.numpy as jnp
from jax import lax
import numpy as np

D_MODEL = 1024
BATCH = 8
SEQ = 2048
DEPTH = 4

CHUNK = 64
N_MEM = 256
MIX_WIDTH = D_MODEL
N_GROUPS = 4
GROUP_WIDTH = MIX_WIDTH // N_GROUPS
HEAD_DIM = 64
N_HEADS_A = GROUP_WIDTH // HEAD_DIM
N_HEADS_C = GROUP_WIDTH // HEAD_DIM
N_HEADS_D = GROUP_WIDTH // HEAD_DIM
CONV_WIDTH_A = 4
POOL_WINDOWS = (2, 4, 8, 16)
POOL_GROUP = GROUP_WIDTH // len(POOL_WINDOWS)
LORA_DECAY = 64
LORA_ICLR = 64
Q_BLOCK = 128
N_MEM_HEADS = 4
MEM_HEAD_DIM = D_MODEL // N_MEM_HEADS
NORM_EPS = 1e-6
GN_EPS = 64e-5
MLSTM_F_BIAS = (3.0, 6.0)
FOX_F_BIAS = (1.0, 4.0)

IN_LAYOUT = (
    ("a_q", GROUP_WIDTH), ("a_k", GROUP_WIDTH), ("a_v", GROUP_WIDTH),
    ("a_i", N_HEADS_A), ("a_f", N_HEADS_A), ("a_z", GROUP_WIDTH),
    ("b_x", GROUP_WIDTH), ("b_z", GROUP_WIDTH),
    ("c_r", GROUP_WIDTH), ("c_k", GROUP_WIDTH), ("c_v", GROUP_WIDTH),
    ("c_w", LORA_DECAY), ("c_a", LORA_ICLR), ("c_z", GROUP_WIDTH),
    ("d_q", GROUP_WIDTH), ("d_k", GROUP_WIDTH), ("d_v", GROUP_WIDTH),
    ("d_f", N_HEADS_D), ("d_z", GROUP_WIDTH),
)
IN_OFFSETS = {name: sum(s for _, s in IN_LAYOUT[:i]) for i, (name, _) in enumerate(IN_LAYOUT)}
IN_SPLITS = tuple(IN_OFFSETS[name] for name, _ in IN_LAYOUT[1:])
N_IN = sum(s for _, s in IN_LAYOUT)
MU_WIDTH = 3 * GROUP_WIDTH + LORA_DECAY + LORA_ICLR
MU_SPLITS = (GROUP_WIDTH, 2 * GROUP_WIDTH, 3 * GROUP_WIDTH, 3 * GROUP_WIDTH + LORA_DECAY)

kernel_name = "hybrid_parallel_group_streaming_encoder"


def rms_norm(x, g):
    x32 = x.astype(jnp.float32)
    y = x32 * lax.rsqrt(jnp.mean(x32 * x32, axis=-1, keepdims=True) + NORM_EPS)
    return (y * g).astype(x.dtype)


def split_heads(u, n_heads):
    b, s, _ = u.shape
    return u.reshape(b, s, n_heads, -1).transpose(0, 2, 1, 3)


def merge_heads(u):
    b, h, s, d = u.shape
    return u.transpose(0, 2, 1, 3).reshape(b, s, h * d)


def causal_depthwise_conv(u, w):
    c, k = u.shape[-1], w.shape[0]
    return lax.conv_general_dilated(
        u, w[:, None, :].astype(u.dtype), window_strides=(1,), padding=[(k - 1, 0)],
        dimension_numbers=("NWC", "WIO", "NWC"), feature_group_count=c)


def token_shift(u, mu):
    prev = jnp.pad(u, ((0, 0), (1, 0), (0, 0)))[:, :-1]
    return u + mu * (prev - u)


def head_rms_norm(y, g):
    y32 = y.astype(jnp.float32)
    y32 = y32 * lax.rsqrt(jnp.mean(y32 * y32, axis=-1, keepdims=True) + NORM_EPS)
    return merge_heads(y32) * g


def mlstm_chunkwise(q, k, v, i_pre, f_pre):
    f32 = jnp.float32
    b_, h_, s_, dh = q.shape
    nc, L = s_ // CHUNK, CHUNK
    qc = q.astype(f32).reshape(b_, h_, nc, L, dh)
    kc = (k.astype(f32) * dh ** -0.5).reshape(b_, h_, nc, L, dh)
    vc = v.astype(f32).reshape(b_, h_, nc, L, dh)
    ig = i_pre.astype(f32).reshape(b_, h_, nc, L)
    bcum = jnp.cumsum(jax.nn.log_sigmoid(f_pre.astype(f32)).reshape(b_, h_, nc, L), axis=-1)
    g = bcum[..., -1]
    w_loc = g[..., None] - bcum + ig
    m_loc = jnp.max(w_loc, axis=-1)
    e_loc = jnp.exp(w_loc - m_loc[..., None])
    c_loc = jnp.einsum("bhcs,bhcsd,bhcse->bhcde", e_loc, vc, kc)
    n_loc = jnp.einsum("bhcs,bhcse->bhce", e_loc, kc)

    def step(carry, xs):
        c_prev, n_prev, m_prev = carry
        g_c, m_l, c_l, n_l = xs
        m_new = jnp.maximum(g_c + m_prev, m_l)
        a = jnp.exp(g_c + m_prev - m_new)
        bb = jnp.exp(m_l - m_new)
        c_new = a[..., None, None] * c_prev + bb[..., None, None] * c_l
        n_new = a[..., None] * n_prev + bb[..., None] * n_l
        return (c_new, n_new, m_new), (c_prev, n_prev, m_prev)

    init = (jnp.zeros((b_, h_, dh, dh), f32), jnp.zeros((b_, h_, dh), f32), jnp.zeros((b_, h_), f32))
    xs = (jnp.moveaxis(g, 2, 0), jnp.moveaxis(m_loc, 2, 0), jnp.moveaxis(c_loc, 2, 0), jnp.moveaxis(n_loc, 2, 0))
    _, (c_in, n_in, m_in) = lax.scan(step, init, xs)
    c_in = jnp.moveaxis(c_in, 0, 2)
    n_in = jnp.moveaxis(n_in, 0, 2)
    m_in = jnp.moveaxis(m_in, 0, 2)
    causal = jnp.tril(jnp.ones((L, L), dtype=bool))
    dmat = jnp.where(causal, bcum[..., :, None] - bcum[..., None, :] + ig[..., None, :], -jnp.inf)
    m_inter = bcum + m_in[..., None]
    m_t = jnp.maximum(m_inter, jnp.max(dmat, axis=-1))
    s_qk = jnp.einsum("bhctd,bhcsd->bhcts", qc, kc) * jnp.exp(dmat - m_t[..., None])
    inter_w = jnp.exp(m_inter - m_t)
    num = jnp.einsum("bhcts,bhcsd->bhctd", s_qk, vc) + inter_w[..., None] * jnp.einsum("bhcde,bhcte->bhctd", c_in, qc)
    den = jnp.sum(s_qk, axis=-1) + inter_w * jnp.einsum("bhce,bhcte->bhct", n_in, qc)
    h = num / jnp.maximum(jnp.abs(den), jnp.exp(-m_t))[..., None]
    return h.reshape(b_, h_, s_, dh)


def multiscale_pool(u, w_pool, scale):
    u32 = u.astype(jnp.float32)
    b_, s_, _ = u.shape
    cs = jnp.cumsum(u32, axis=1)
    pos = jnp.arange(s_, dtype=jnp.float32)
    outs = []
    for gi, win in enumerate(POOL_WINDOWS):
        sl = slice(gi * POOL_GROUP, (gi + 1) * POOL_GROUP)
        cg = cs[..., sl]
        shifted = jnp.pad(cg, ((0, 0), (win, 0), (0, 0)))[:, :s_]
        count = jnp.minimum(pos + 1.0, float(win))
        outs.append((cg - shifted) / count[None, :, None] - u32[..., sl])
    pooled = jnp.stack(outs, axis=2)
    mixed = jnp.einsum("bsgc,gcd->bsgd", pooled, w_pool).reshape(b_, s_, GROUP_WIDTH)
    return mixed * scale


def rwkv7_time_mix(r, k, v, w_lo, a_lo, mu, w0, w2, a0, a2, key_k, key_a, bonus_u, gn_g, gn_b):
    f32 = jnp.float32
    mu_r, mu_k, mu_v, mu_w, mu_a = jnp.split(mu.astype(f32), MU_SPLITS)
    r = token_shift(r.astype(f32), mu_r)
    k = token_shift(k.astype(f32), mu_k)
    v = token_shift(v.astype(f32), mu_v)
    w_lo = token_shift(w_lo.astype(f32), mu_w)
    a_lo = token_shift(a_lo.astype(f32), mu_a)
    w_log = -jax.nn.softplus(-(w0 + jnp.tanh(w_lo) @ w2.astype(f32))) - 0.5
    decay = jnp.exp(-jnp.exp(w_log))
    a = jax.nn.sigmoid(a0 + a_lo @ a2.astype(f32))
    b_, s_, _ = r.shape
    hsplit = lambda u: u.reshape(b_, s_, N_HEADS_C, HEAD_DIM)
    kk = hsplit(k * key_k)
    kk = kk / jnp.maximum(jnp.sqrt(jnp.sum(kk * kk, axis=-1, keepdims=True)), 1e-12)
    k = k * (1.0 + (a - 1.0) * key_a)
    rh, kh, vh, wh, ah = hsplit(r), hsplit(k), hsplit(v), hsplit(decay), hsplit(a)

    def step(state, xs):
        r_t, k_t, v_t, w_t, kk_t, a_t = xs
        sa = jnp.einsum("bhvk,bhk->bhv", state, -kk_t)
        state = state * w_t[:, :, None, :] + sa[..., None] * (kk_t * a_t)[:, :, None, :] + v_t[..., None] * k_t[:, :, None, :]
        return state, jnp.einsum("bhvk,bhk->bhv", state, r_t)

    xs = tuple(u.transpose(1, 0, 2, 3) for u in (rh, kh, vh, wh, kk, ah))
    init = jnp.zeros((b_, N_HEADS_C, HEAD_DIM, HEAD_DIM), f32)
    _, y = lax.scan(step, init, xs)
    y = y.transpose(1, 0, 2, 3)
    mean = jnp.mean(y, axis=-1, keepdims=True)
    var = jnp.mean(jnp.square(y - mean), axis=-1, keepdims=True)
    y = ((y - mean) * lax.rsqrt(var + GN_EPS)).reshape(b_, s_, GROUP_WIDTH) * gn_g + gn_b
    bonus = jnp.sum(rh * kh * bonus_u.astype(f32).reshape(N_HEADS_C, HEAD_DIM), axis=-1, keepdims=True) * vh
    return y + bonus.reshape(b_, s_, GROUP_WIDTH)


def forgetting_attention(q, k, v, f_pre, qk_g):
    dh, s_len = q.shape[-1], q.shape[2]
    q = rms_norm(q, qk_g[0]) * (dh ** -0.5)
    k = rms_norm(k, qk_g[1])
    log_f_cum = jnp.cumsum(jax.nn.log_sigmoid(f_pre.astype(jnp.float32)), axis=-1)
    outs = []
    for blk in range(s_len // Q_BLOCK):
        q0, q1 = blk * Q_BLOCK, (blk + 1) * Q_BLOCK
        logits = jnp.einsum("bhtd,bhsd->bhts", q[:, :, q0:q1], k[:, :, :q1]).astype(jnp.float32)
        logits = logits + log_f_cum[:, :, q0:q1, None] - log_f_cum[:, :, None, :q1]
        causal = (q0 + jnp.arange(Q_BLOCK))[:, None] >= jnp.arange(q1)[None, :]
        p = jax.nn.softmax(jnp.where(causal, logits, -jnp.inf), axis=-1)
        outs.append(jnp.einsum("bhts,bhsd->bhtd", p.astype(v.dtype), v[:, :, :q1]))
    return jnp.concatenate(outs, axis=2)


def memory_cross_attention(h, mem_n, wq, wkv, wo):
    q = split_heads(h @ wq, N_MEM_HEADS)
    k, v = jnp.split(mem_n @ wkv, 2, axis=-1)
    k, v = split_heads(k, N_MEM_HEADS), split_heads(v, N_MEM_HEADS)
    logits = jnp.einsum("bhtd,bhmd->bhtm", q, k).astype(jnp.float32) * (MEM_HEAD_DIM ** -0.5)
    p = jax.nn.softmax(logits, axis=-1)
    o = jnp.einsum("bhtm,bhmd->bhtd", p.astype(v.dtype), v)
    return merge_heads(o) @ wo


def setup_inputs(seed: int = 0) -> dict:
    key = jax.random.key(seed)
    ks = jax.random.split(key, 32)
    f32 = jnp.float32
    nrm = lambda kk, shape, scale: scale * jax.random.normal(kk, shape, f32)
    L, D, GW = DEPTH, D_MODEL, GROUP_WIDTH
    b_in = nrm(ks[5], (L, N_IN), 0.02)
    fa, fd = IN_OFFSETS["a_f"], IN_OFFSETS["d_f"]
    b_in = b_in.at[:, fa:fa + N_HEADS_A].add(jnp.linspace(MLSTM_F_BIAS[0], MLSTM_F_BIAS[1], N_HEADS_A, dtype=f32))
    b_in = b_in.at[:, fd:fd + N_HEADS_D].add(jnp.linspace(FOX_F_BIAS[0], FOX_F_BIAS[1], N_HEADS_D, dtype=f32))
    return {
        "x": nrm(ks[0], (BATCH, SEQ, D), 1.0),
        "mem": nrm(ks[1], (BATCH, N_MEM, D), 1.0),
        "pre_norm_g": 1.0 + nrm(ks[2], (L, D), 0.05),
        "post_norm_g": 1.0 + nrm(ks[3], (L, D), 0.05),
        "w_in": nrm(ks[4], (L, D, N_IN), D ** -0.5),
        "b_in": b_in,
        "conv_a": nrm(ks[6], (L, CONV_WIDTH_A, 2 * GW), CONV_WIDTH_A ** -0.5),
        "norm_a_g": 1.0 + nrm(ks[7], (L, GW), 0.05),
        "pool_w": nrm(ks[8], (L, len(POOL_WINDOWS), POOL_GROUP, POOL_GROUP), POOL_GROUP ** -0.5),
        "pool_scale": 0.5 + nrm(ks[9], (L, GW), 0.05),
        "shift_mu_c": jax.random.uniform(ks[10], (L, MU_WIDTH), f32),
        "decay_w0": jax.random.uniform(ks[11], (L, GW), f32, -3.0, 1.0),
        "decay_w2": nrm(ks[12], (L, LORA_DECAY, GW), 0.1),
        "iclr_a0": nrm(ks[13], (L, GW), 0.1),
        "iclr_a2": nrm(ks[14], (L, LORA_ICLR, GW), 0.1),
        "key_k": 0.85 + nrm(ks[15], (L, GW), 0.05),
        "key_a": 1.0 + nrm(ks[16], (L, GW), 0.05),
        "bonus_u": nrm(ks[17], (L, GW), 0.1),
        "gn_c_g": 1.0 + nrm(ks[18], (L, GW), 0.05),
        "gn_c_b": nrm(ks[19], (L, GW), 0.02),
        "qk_norm_d": 1.0 + nrm(ks[20], (L, 2, HEAD_DIM), 0.05),
        "w_out": nrm(ks[21], (L, MIX_WIDTH, D), MIX_WIDTH ** -0.5),
        "mem_norm_g": 1.0 + nrm(ks[22], (D,), 0.05),
        "xattn_pre_g": 1.0 + nrm(ks[23], (L, D), 0.05),
        "xattn_post_g": 1.0 + nrm(ks[24], (L, D), 0.05),
        "xattn_wq": nrm(ks[25], (L, D, D), D ** -0.5),
        "xattn_wkv": nrm(ks[26], (L, D, 2 * D), D ** -0.5),
        "xattn_wo": nrm(ks[27], (L, D, D), D ** -0.5),
    }


def reference(x, mem, pre_norm_g, post_norm_g, w_in, b_in, conv_a, norm_a_g, pool_w, pool_scale,
              shift_mu_c, decay_w0, decay_w2, iclr_a0, iclr_a2, key_k, key_a, bonus_u, gn_c_g, gn_c_b,
              qk_norm_d, w_out, mem_norm_g, xattn_pre_g, xattn_post_g, xattn_wq, xattn_wkv, xattn_wo):
    mem_n = rms_norm(mem, mem_norm_g)
    for l in range(DEPTH):
        h = rms_norm(x, pre_norm_g[l])
        proj = h @ w_in[l] + b_in[l]
        (a_q, a_k, a_v, a_i, a_f, a_z, b_x, b_z, c_r, c_k, c_v, c_w, c_a, c_z,
         d_q, d_k, d_v, d_f, d_z) = jnp.split(proj, IN_SPLITS, axis=-1)
        a_qk = jax.nn.silu(causal_depthwise_conv(jnp.concatenate([a_q, a_k], axis=-1), conv_a[l]))
        a_q, a_k = jnp.split(a_qk, 2, axis=-1)
        h_a = mlstm_chunkwise(split_heads(a_q, N_HEADS_A), split_heads(a_k, N_HEADS_A),
                              split_heads(a_v, N_HEADS_A), a_i.transpose(0, 2, 1), a_f.transpose(0, 2, 1))
        y_a = head_rms_norm(h_a, norm_a_g[l]) * jax.nn.silu(a_z)
        y_b = multiscale_pool(b_x, pool_w[l], pool_scale[l]) * jax.nn.silu(b_z)
        y_c = rwkv7_time_mix(c_r, c_k, c_v, c_w, c_a, shift_mu_c[l], decay_w0[l], decay_w2[l],
                             iclr_a0[l], iclr_a2[l], key_k[l], key_a[l], bonus_u[l],
                             gn_c_g[l], gn_c_b[l]) * jax.nn.silu(c_z)
        h_d = forgetting_attention(split_heads(d_q, N_HEADS_D), split_heads(d_k, N_HEADS_D),
                                   split_heads(d_v, N_HEADS_D), d_f.transpose(0, 2, 1), qk_norm_d[l])
        y_d = merge_heads(h_d) * jax.nn.silu(d_z)
        y = jnp.concatenate([u.astype(x.dtype) for u in (y_a, y_b, y_c, y_d)], axis=-1) @ w_out[l]
        x = x + rms_norm(y, post_norm_g[l])
        hm = rms_norm(x, xattn_pre_g[l])
        x = x + rms_norm(memory_cross_attention(hm, mem_n, xattn_wq[l], xattn_wkv[l], xattn_wo[l]),
                         xattn_post_g[l])
    return x
```

```cpp
#include <hip/hip_runtime.h>
#include <hip/hip_cooperative_groups.h>
#include <cstdio>
#include <cstdint>
namespace cg = cooperative_groups;
#define GAS __attribute__((address_space(1)))
#define LAS __attribute__((address_space(3)))
namespace pg8 {
#define PG8_LAS __attribute__((address_space(3)))
typedef unsigned short bf16_t;
typedef short bf16x8 __attribute__((ext_vector_type(8)));
typedef float f32x4 __attribute__((ext_vector_type(4)));
typedef unsigned u32x4 __attribute__((ext_vector_type(4)));
constexpr int BM = 256, BK = 64, HALF = 128, HTB = HALF * BK * 2  , STAGE_BYTES = 8 * HTB, NXCD = 8, WGM = 8;

__host__ __device__ __forceinline__ int lds_byte(int r, int c) { const int st = (r >> 4) * 2 + (c >> 5), rr = r & 15, cc = c & 31, ob = rr * 64 + cc * 2; return st * 1024 + (ob ^ (((ob >> 9) & 1) << 5)); }
__host__ __device__ __forceinline__ void stage_rc(int b, int& R, int& C) { const int st = b / 1024, sb = b % 1024, swz = sb ^ (((sb >> 9) & 1) << 5); R = (st >> 1) * 16 + swz / 64; C = (st & 1) * 32 + (swz % 64) / 2; }
__host__ __device__ __forceinline__ int perm32(int rho) { const int n = rho >> 4, i = rho & 15; return 8 * (i >> 2) + 4 * n + (i & 3); }

struct Unit { int pm, pn; };
struct Gemm { const bf16_t* A; const bf16_t* Bt; int M, N, K; };

struct StaticOrder {
    int nM, nN, nwg, G, c;
    __host__ __device__ void init(int M, int N, int G_, int c_) { nM = M / BM; nN = N / BM; nwg = nM * nN; G = G_; c = c_; }
    __host__ __device__ bool next(int i, Unit& u) const {
        const long L = (long)i * G + c; if (L >= nwg) return false;
        int wgid = (int)L; { const int q = nwg / NXCD, r = nwg % NXCD, xcd = wgid % NXCD, off = wgid / NXCD; wgid = (xcd < r ? xcd * (q + 1) : r * (q + 1) + (xcd - r) * q) + off; }
        const int nig = WGM * nN, gid = wgid / nig, fm = gid * WGM, gsz = (nM - fm) < WGM ? (nM - fm) : WGM;
        u.pm = fm + ((wgid % nig) % gsz); u.pn = (wgid % nig) / gsz; return true;
    }
    __device__ __forceinline__ void a_ready(const Unit&) const {}
    __device__ __forceinline__ void done(const Unit&) const {}
};

__device__ __forceinline__ unsigned cvt_pk_bf16(float lo, float hi) { unsigned r; asm volatile("v_cvt_pk_bf16_f32 %0, %1, %2" : "=v"(r) : "v"(lo), "v"(hi)); return r; }

struct EpiProj {
    static constexpr bool PERM = true, AFTER_DRAIN = false;
    bf16_t* O; int ldc; int ncol_store; const float* bias; float* gatesT; int gcol0; int M;
    __device__ __forceinline__ void operator()(const f32x4 (&acc)[2][2][4][2], const Unit& u, int wr, int wc, int fr, int fq) const {
        const int row0 = u.pm * BM + wr * 64 + fr; const int col0 = u.pn * BM + wc * 32 + 8 * fq;
        f32x4 bv[2][2];
#pragma unroll
        for (int bj = 0; bj < 2; ++bj)
#pragma unroll
            for (int n = 0; n < 2; ++n) bv[bj][n] = *(const f32x4*)(bias + col0 + bj * HALF + 4 * n);
#pragma unroll
        for (int ai = 0; ai < 2; ++ai)
#pragma unroll
            for (int m = 0; m < 4; ++m) { const int row = row0 + ai * HALF + m * 16; bf16_t* rowp = O + (size_t)row * ldc;
#pragma unroll
                for (int bj = 0; bj < 2; ++bj) { const int c = col0 + bj * HALF; const f32x4 v0 = acc[ai][bj][m][0] + bv[bj][0], v1 = acc[ai][bj][m][1] + bv[bj][1];
                    if (c < ncol_store) { u32x4 w; w.x = cvt_pk_bf16(v0[0], v0[1]); w.y = cvt_pk_bf16(v0[2], v0[3]); w.z = cvt_pk_bf16(v1[0], v1[1]); w.w = cvt_pk_bf16(v1[2], v1[3]); *(u32x4*)(rowp + c) = w; }
                    if (c >= gcol0 && c < gcol0 + 16) { float* g = gatesT + (size_t)(c - gcol0) * M + row;
                        g[0] = v0[0]; g[(size_t)M] = v0[1]; g[(size_t)2 * M] = v0[2]; g[(size_t)3 * M] = v0[3]; g[(size_t)4 * M] = v1[0]; g[(size_t)5 * M] = v1[1]; g[(size_t)6 * M] = v1[2]; g[(size_t)7 * M] = v1[3]; } } }
    }
};
struct EpiB16 {
    static constexpr bool PERM = true, AFTER_DRAIN = false;
    bf16_t* O; int ldc;
    __device__ __forceinline__ void operator()(const f32x4 (&acc)[2][2][4][2], const Unit& u, int wr, int wc, int fr, int fq) const {
        const int row0 = u.pm * BM + wr * 64 + fr; const int col0 = u.pn * BM + wc * 32 + 8 * fq;
#pragma unroll
        for (int ai = 0; ai < 2; ++ai)
#pragma unroll
            for (int m = 0; m < 4; ++m) { bf16_t* rowp = O + (size_t)(row0 + ai * HALF + m * 16) * ldc + col0;
#pragma unroll
                for (int bj = 0; bj < 2; ++bj) { const f32x4 v0 = acc[ai][bj][m][0], v1 = acc[ai][bj][m][1];
                    u32x4 w; w.x = cvt_pk_bf16(v0[0], v0[1]); w.y = cvt_pk_bf16(v0[2], v0[3]); w.z = cvt_pk_bf16(v1[0], v1[1]); w.w = cvt_pk_bf16(v1[2], v1[3]); *(u32x4*)(rowp + bj * HALF) = w; } }
    }
};
struct EpiF32 {
    static constexpr bool PERM = false, AFTER_DRAIN = false;
    float* O; int ldc;
    __device__ __forceinline__ void operator()(const f32x4 (&acc)[2][2][4][2], const Unit& u, int wr, int wc, int fr, int fq) const {
        const int row0 = u.pm * BM + wr * 64 + fr; const int col0 = u.pn * BM + wc * 32 + 4 * fq;
#pragma unroll
        for (int ai = 0; ai < 2; ++ai)
#pragma unroll
            for (int m = 0; m < 4; ++m) { float* rowp = O + (size_t)(row0 + ai * HALF + m * 16) * ldc + col0;
#pragma unroll
                for (int bj = 0; bj < 2; ++bj)
#pragma unroll
                    for (int n = 0; n < 2; ++n) *(f32x4*)(rowp + bj * HALF + n * 16) = acc[ai][bj][m][n]; }
    }
};

template <class Epi, class Sched, bool ALIGN_EPI = false, bool SP2 = false>
__device__ __forceinline__ void gemm_phase(PG8_LAS unsigned char* lds, const Gemm g, const Sched& S, const Epi& E) {
    int tid_ = threadIdx.x; asm volatile("" : "+v"(tid_)); const int tid = tid_, wid = __builtin_amdgcn_readfirstlane(tid >> 6), lane = tid & 63, wr = wid >> 2, wc = wid & 3, fr = lane & 15, fq = lane >> 4;
    const int K = g.K, nt = K / BK;
    unsigned voffA[2], voffB[2];
#pragma unroll
    for (int i = 0; i < 2; ++i) { int R, C; stage_rc(tid * 16 + i * 8192, R, C); const int Rb = Epi::PERM ? ((R & ~31) + perm32(R & 31)) : R;
        voffA[i] = (unsigned)(R * K + C) * 2u; voffB[i] = (unsigned)(Rb * K + C) * 2u; }
    const size_t kstep = (size_t)(BK * 2);
    const size_t hstep = (size_t)HALF * K * 2;
    const size_t tstep = 2 * hstep;
    const unsigned ldsw = (unsigned)wid * 1024u;
    const int aoff = lds_byte(wr * 64 + fr, fq * 8), boff = lds_byte(wc * 32 + fr, fq * 8);
#define PG8_SA(b, h) (((b) * 2 + (h)) * HTB)
#define PG8_SB(b, h) ((4 + (b) * 2 + (h)) * HTB)
#define PG8_STAGE(bufoff, gbase, voff) do { _Pragma("unroll") for (int _i = 0; _i < 2; ++_i) \
        __builtin_amdgcn_global_load_lds((const unsigned*)((const char*)(gbase) + (voff)[_i]), (PG8_LAS unsigned*)(lds + (bufoff) + ldsw + _i * 8192), 16, 0, 0); } while (0)
#define PG8_LDA(dst, b, h) do { _Pragma("unroll") for (int m = 0; m < 4; ++m) _Pragma("unroll") for (int k = 0; k < 2; ++k) dst[m][k] = *(const PG8_LAS bf16x8*)(lds + PG8_SA(b, h) + aoff + m * 2048 + k * 1024); } while (0)
#define PG8_LDB(dst, b, h) do { _Pragma("unroll") for (int n = 0; n < 2; ++n) _Pragma("unroll") for (int k = 0; k < 2; ++k) dst[n][k] = *(const PG8_LAS bf16x8*)(lds + PG8_SB(b, h) + boff + n * 2048 + k * 1024); } while (0)
#define PG8_MMA(ai, bj, At, Bt) do { __builtin_amdgcn_s_setprio(1); _Pragma("unroll") for (int m = 0; m < 4; ++m) _Pragma("unroll") for (int n = 0; n < 2; ++n) _Pragma("unroll") for (int k = 0; k < 2; ++k) \
        acc[ai][bj][m][n] = __builtin_amdgcn_mfma_f32_16x16x32_bf16(Bt[n][k], At[m][k], acc[ai][bj][m][n], 0, 0, 0); __builtin_amdgcn_s_setprio(0); } while (0)
#define PG8_WAIT_V(n) asm volatile("s_waitcnt vmcnt(" #n ")" ::: "memory")
#define PG8_WAIT_L(n) asm volatile("s_waitcnt lgkmcnt(" #n ")" ::: "memory")
#define PG8_BAR __builtin_amdgcn_s_barrier()
#define PG8_SCHED __builtin_amdgcn_sched_barrier(0)
    Unit cur, nxt; int ui = 0;
    if (!S.next(0, cur)) return;
    f32x4 acc[2][2][4][2];
#pragma unroll
    for (int a = 0; a < 2; ++a)
#pragma unroll
        for (int b = 0; b < 2; ++b)
#pragma unroll
            for (int m = 0; m < 4; ++m)
#pragma unroll
                for (int n = 0; n < 2; ++n) acc[a][b][m][n] = (f32x4){0.f, 0.f, 0.f, 0.f};
    bf16x8 At[4][2], B0[2][2], B1[2][2];
    const char* cA = (const char*)g.A + (size_t)cur.pm * tstep; const char* cB = (const char*)g.Bt + (size_t)cur.pn * tstep;
    S.a_ready(cur);
    if constexpr (SP2) {
        PG8_STAGE(PG8_SB(0, 0), cB, voffB); PG8_STAGE(PG8_SB(0, 1), cB + hstep, voffB); PG8_STAGE(PG8_SA(0, 0), cA, voffA); PG8_STAGE(PG8_SA(0, 1), cA + hstep, voffA);
        if (wr == 1) PG8_BAR;
        PG8_WAIT_V(2); PG8_BAR;
        PG8_STAGE(PG8_SB(1, 0), cB + kstep, voffB); PG8_STAGE(PG8_SA(1, 0), cA + kstep, voffA); PG8_STAGE(PG8_SB(1, 1), cB + hstep + kstep, voffB);
        PG8_WAIT_V(6); PG8_BAR;
    } else {
        PG8_STAGE(PG8_SB(0, 0), cB, voffB); PG8_STAGE(PG8_SA(0, 0), cA, voffA); PG8_STAGE(PG8_SB(0, 1), cB + hstep, voffB); PG8_STAGE(PG8_SA(0, 1), cA + hstep, voffA);
        if (wr == 1) PG8_BAR;
        PG8_WAIT_V(4); PG8_BAR;
        PG8_STAGE(PG8_SB(1, 0), cB + kstep, voffB); PG8_STAGE(PG8_SA(1, 0), cA + kstep, voffA); PG8_STAGE(PG8_SB(1, 1), cB + hstep + kstep, voffB);
        PG8_WAIT_V(6); PG8_BAR;
    }
    for (;;) {
        const bool has_next = S.next(ui + 1, nxt);
        const char* nA = has_next ? (const char*)g.A + (size_t)nxt.pm * tstep : cA; const char* nB = has_next ? (const char*)g.Bt + (size_t)nxt.pn * tstep : cB;
        for (int t = 0; t < nt; t += 2) {
            const bool last = (t == nt - 2);
            const char* a1 = cA + (size_t)(t + 1) * kstep;
            const char* a2 = last ? nA : cA + (size_t)(t + 2) * kstep; const char* b2 = last ? nB : cB + (size_t)(t + 2) * kstep;
            const char* a3 = a2 + kstep; const char* b3 = b2 + kstep;
            if (last && has_next) S.a_ready(nxt);
            if constexpr (SP2) {
            PG8_LDB(B0, 0, 0); PG8_LDB(B1, 0, 1); PG8_SCHED; PG8_LDA(At, 0, 0); PG8_STAGE(PG8_SA(1, 1), a1 + hstep, voffA);
            PG8_WAIT_V(8); PG8_WAIT_L(0); PG8_BAR; PG8_MMA(0, 0, At, B0); PG8_MMA(0, 1, At, B1); PG8_BAR; PG8_SCHED;
            PG8_LDA(At, 0, 1); PG8_STAGE(PG8_SB(0, 0), b2, voffB); PG8_STAGE(PG8_SB(0, 1), b2 + hstep, voffB); PG8_STAGE(PG8_SA(0, 0), a2, voffA);
            PG8_WAIT_V(8); PG8_WAIT_L(0); PG8_BAR; PG8_MMA(1, 0, At, B0); PG8_MMA(1, 1, At, B1); PG8_BAR; PG8_SCHED;
            PG8_LDB(B0, 1, 0); PG8_LDB(B1, 1, 1); PG8_SCHED; PG8_LDA(At, 1, 0); PG8_STAGE(PG8_SA(0, 1), a2 + hstep, voffA);
            PG8_WAIT_V(8); PG8_WAIT_L(0); PG8_BAR; PG8_MMA(0, 0, At, B0); PG8_MMA(0, 1, At, B1); PG8_BAR; PG8_SCHED;
            PG8_LDA(At, 1, 1); PG8_STAGE(PG8_SB(1, 0), b3, voffB); PG8_STAGE(PG8_SB(1, 1), b3 + hstep, voffB); PG8_STAGE(PG8_SA(1, 0), a3, voffA);
            PG8_WAIT_V(8); PG8_WAIT_L(0); PG8_BAR; PG8_MMA(1, 0, At, B0); PG8_MMA(1, 1, At, B1); PG8_BAR; PG8_SCHED;
            } else {
            PG8_LDB(B0, 0, 0); PG8_SCHED; PG8_LDA(At, 0, 0); PG8_STAGE(PG8_SA(1, 1), a1 + hstep, voffA);
            PG8_WAIT_L(8); PG8_BAR; PG8_WAIT_L(0); PG8_MMA(0, 0, At, B0); PG8_BAR; PG8_SCHED;
            PG8_LDB(B1, 0, 1); PG8_STAGE(PG8_SB(0, 0), b2, voffB);
            PG8_BAR; PG8_WAIT_L(0); PG8_MMA(0, 1, At, B1); PG8_BAR;
            PG8_LDA(At, 0, 1); PG8_STAGE(PG8_SA(0, 0), a2, voffA);
            PG8_BAR; PG8_WAIT_L(0); PG8_MMA(1, 0, At, B0); PG8_BAR; PG8_SCHED;
            PG8_STAGE(PG8_SB(0, 1), b2 + hstep, voffB);
            PG8_WAIT_V(6); PG8_BAR; PG8_MMA(1, 1, At, B1); PG8_BAR;
            PG8_LDB(B0, 1, 0); PG8_SCHED; PG8_LDA(At, 1, 0); PG8_STAGE(PG8_SA(0, 1), a2 + hstep, voffA);
            PG8_WAIT_L(8); PG8_BAR; PG8_WAIT_L(0); PG8_MMA(0, 0, At, B0); PG8_BAR; PG8_SCHED;
            PG8_LDB(B1, 1, 1); PG8_STAGE(PG8_SB(1, 0), b3, voffB);
            PG8_BAR; PG8_WAIT_L(0); PG8_MMA(0, 1, At, B1); PG8_BAR;
            PG8_LDA(At, 1, 1); PG8_STAGE(PG8_SA(1, 0), a3, voffA);
            PG8_BAR; PG8_WAIT_L(0); PG8_MMA(1, 0, At, B0); PG8_BAR; PG8_SCHED;
            PG8_STAGE(PG8_SB(1, 1), b3 + hstep, voffB);
            PG8_WAIT_V(6); PG8_BAR; PG8_MMA(1, 1, At, B1); PG8_BAR;
            }
        }
        if constexpr (ALIGN_EPI) { if (wr == 0) PG8_BAR; }
        if constexpr (!Epi::AFTER_DRAIN) { E(acc, cur, wr, wc, fr, fq); S.done(cur); }
        if (!has_next) break;
#pragma unroll
        for (int a = 0; a < 2; ++a)
#pragma unroll
            for (int b = 0; b < 2; ++b)
#pragma unroll
                for (int m = 0; m < 4; ++m)
#pragma unroll
                    for (int n = 0; n < 2; ++n) acc[a][b][m][n] = (f32x4){0.f, 0.f, 0.f, 0.f};
        cur = nxt; cA = nA; cB = nB; ++ui;
        if constexpr (ALIGN_EPI) { if (wr == 1) PG8_BAR; }
    }
    PG8_WAIT_V(0);
    if constexpr (!ALIGN_EPI) { if (wr == 0) PG8_BAR; }
    PG8_BAR;
    if constexpr (Epi::AFTER_DRAIN) { E.fused(acc, cur, wr, wc, fr, fq, lds, wid, lane); S.done(cur); }
#undef PG8_SA
#undef PG8_SB
#undef PG8_STAGE
#undef PG8_LDA
#undef PG8_LDB
#undef PG8_MMA
#undef PG8_WAIT_V
#undef PG8_WAIT_L
#undef PG8_BAR
#undef PG8_SCHED
}
}
#define XB_TMO      128
#define XB_XCNT(j)  (256  + 64 * (j))
#define XB_XSUB(j)  (1280 + 64 * (j))
#define XB_XGEN(j)  (2304 + 64 * (j))
#define XB_TOP      3328
#define XB_TOPGEN   3392
#define XCD_BAR_WORDS 3456
#define XB_SPIN_CAP (1u << 18)

__device__ __forceinline__ unsigned xb_ld(unsigned* p)              { return __hip_atomic_load(p, __ATOMIC_RELAXED, __HIP_MEMORY_SCOPE_AGENT); }
__device__ __forceinline__ unsigned xb_add(unsigned* p, unsigned v) { return __hip_atomic_fetch_add(p, v, __ATOMIC_RELAXED, __HIP_MEMORY_SCOPE_AGENT); }
__device__ __forceinline__ unsigned xb_xcc_id() { return (unsigned)__builtin_amdgcn_s_getreg((3 << 11) | 20) & 0xFu; }
#define XB_SPIN(cond, bar) do { unsigned _sp = 0; while (cond) { __builtin_amdgcn_s_sleep(1); \
    if ((++_sp & 255u) == 0u) { if (xb_ld(&(bar)[XB_TMO])) break; if (_sp > XB_SPIN_CAP) { atomicAdd(&(bar)[XB_TMO], 1u); break; } } } } while (0)

struct XcdBarrier {
    unsigned* bar; unsigned x;
    volatile LAS unsigned* st;
};

__device__ __forceinline__ XcdBarrier xcd_barrier_post(unsigned* bar, volatile LAS unsigned* st) {
    XcdBarrier b; b.bar = bar; b.x = xb_xcc_id(); b.st = st;
    if (threadIdx.x == 0) (void)xb_add(&bar[XB_XCNT(b.x)], 1u);
    return b;
}
__device__ __forceinline__ void xcd_barrier_complete(unsigned* bar, unsigned x, unsigned& nloc, unsigned& nx) {
    const unsigned G = gridDim.x * gridDim.y * gridDim.z;
    unsigned sum, cnt, mine, sp = 0u;
    for (;;) {
        sum = 0u; cnt = 0u; mine = 0u;
#pragma unroll
        for (unsigned j = 0; j < 16; ++j) { const unsigned c = xb_ld(&bar[XB_XCNT(j)]); sum += c; cnt += (c > 0u) ? 1u : 0u; mine = (j == x) ? c : mine; }
        if (sum == G) break;
        __builtin_amdgcn_s_sleep(1);
        if ((++sp & 255u) == 0u) { if (xb_ld(&bar[XB_TMO])) break; if (sp > XB_SPIN_CAP) { atomicAdd(&bar[XB_TMO], 1u); break; } }
    }
    nloc = mine > 0u ? mine : 1u; nx = cnt > 0u ? cnt : 1u;
}

__device__ __forceinline__ void xcd_barrier(const XcdBarrier& b) {
    asm volatile("s_waitcnt vmcnt(0)" ::: "memory");
    __syncthreads();
    if (threadIdx.x == 0) {
        unsigned* bar = b.bar;
        __builtin_amdgcn_s_waitcnt(0);
        unsigned nloc = b.st[0], nx = b.st[1];
        if (nloc == 0u) { xcd_barrier_complete(bar, b.x, nloc, nx); b.st[0] = nloc; b.st[1] = nx; }
        const unsigned old = xb_add(&bar[XB_XSUB(b.x)], 1u);
        const unsigned gen = old / nloc;
        if (old + 1u == (gen + 1u) * nloc) {
            __builtin_amdgcn_fence(__ATOMIC_RELEASE, "agent");
            asm volatile("s_waitcnt vmcnt(0)" ::: "memory");
            const unsigned og = xb_add(&bar[XB_TOP], 1u);
            const unsigned tg = og / nx;
            if (og + 1u == (tg + 1u) * nx) xb_add(&bar[XB_TOPGEN], 1u);
            else XB_SPIN(xb_ld(&bar[XB_TOPGEN]) == tg, bar);
            __builtin_amdgcn_fence(__ATOMIC_ACQUIRE, "agent");
            xb_add(&bar[XB_XGEN(b.x)], 1u);
            asm volatile("s_waitcnt vmcnt(0)" ::: "memory");
        } else {
            XB_SPIN(xb_ld(&bar[XB_XGEN(b.x)]) == gen, bar);
            __builtin_amdgcn_fence(__ATOMIC_ACQUIRE, "agent");
            asm volatile("s_waitcnt vmcnt(0)" ::: "memory");
        }
    }
    __syncthreads();
}

typedef unsigned short bf16;
typedef unsigned v4u __attribute__((ext_vector_type(4)));
typedef unsigned v2u __attribute__((ext_vector_type(2)));
typedef float f32x4 __attribute__((ext_vector_type(4)));
typedef float f32x2 __attribute__((ext_vector_type(2)));
constexpr int NWAVES = 8, NTHR = 512;
constexpr int BATCH = 8, SEQ = 2048, DM = 1024, MTOK = BATCH * SEQ, DEPTH = 4, NMEM = 256, MMEM = BATCH * NMEM;
constexpr int NIN = 3724, NINP = 3840, PP = 3736;
constexpr int P_AQ = 0, P_AK = 256, P_AV = 512, P_AZ = 768, P_BX = 1024, P_BZ = 1280, P_CR = 1536, P_CK = 1792, P_CV = 2048, P_CW = 2304, P_CA = 2368, P_CZ = 2432,
              P_DQ = 2688, P_DK = 2944, P_DV = 3200, P_DZ = 3456, P_G = 3712;
constexpr float NORM_EPS = 1e-6f, GN_EPS = 64e-5f;
constexpr size_t MiB = 1u << 20;
constexpr size_t WS_CTL = 0, CTL_ZERO_BYTES = 1 * MiB;
constexpr size_t WS_WIN = 1 * MiB, WS_WOUT = 9 * MiB, WS_WQ = 11 * MiB, WS_WO = 13 * MiB, WS_WKV = 15 * MiB;
constexpr size_t WS_KV = 19 * MiB;
constexpr size_t WS_MEMN = 27 * MiB;
constexpr size_t WS_BIASP = 254 * MiB;
constexpr size_t WS_BUFA = 31 * MiB;
constexpr size_t WS_BUFP = 63 * MiB;
constexpr size_t WS_GATES = 180 * MiB;
constexpr size_t WS_CUM = 181 * MiB;
constexpr size_t WS_SBON = 181 * MiB + 512 * 1024;
constexpr size_t WS_RR = 182 * MiB, WS_RK = 190 * MiB, WS_RV = 198 * MiB, WS_RKK = 206 * MiB, WS_RB = 214 * MiB;
constexpr size_t WS_RW = 222 * MiB;
constexpr size_t WS_YRAW = 238 * MiB;
constexpr size_t WS_END = 255 * MiB;
static_assert(WS_MEMN + (size_t)MMEM * DM * 2 <= WS_BUFA && WS_BIASP + NINP * 4 <= WS_END, "ws map");
static_assert(WS_BUFP + (size_t)MTOK * PP * 2 <= WS_GATES, "ws map: proj");
constexpr int CW_BAR = 4096;
constexpr int RING_BYTES = 131072, LDSCTL_OFF = RING_BYTES, MISC_OFF = LDSCTL_OFF + 320, LDS_BYTES = 147456;

__device__ __forceinline__ unsigned f2bf(float f) { unsigned u = __builtin_bit_cast(unsigned, f); return (u + 0x7fffu + ((u >> 16) & 1u)) >> 16; }
__device__ __forceinline__ unsigned pk2(float lo, float hi) { return f2bf(lo) | (f2bf(hi) << 16); }
__device__ __forceinline__ float bflo(unsigned w) { return __uint_as_float(w << 16); }
__device__ __forceinline__ float bfhi(unsigned w) { return __uint_as_float(w & 0xffff0000u); }
__device__ __forceinline__ float bf1(bf16 h) { return __uint_as_float((unsigned)h << 16); }
__device__ __forceinline__ float silu_f(float x) { return x / (1.f + __expf(-x)); }
__device__ __forceinline__ float sigmoid_f(float x) { return 1.f / (1.f + __expf(-x)); }
__device__ __forceinline__ float softplus_f(float x) { return fmaxf(x, 0.f) + log1pf(__expf(-fabsf(x))); }
__device__ __forceinline__ float logsigmoid_f(float x) { return fminf(x, 0.f) - log1pf(__expf(-fabsf(x))); }
__device__ __forceinline__ float wave_sum(float v) {
#pragma unroll
    for (int o = 1; o < 64; o <<= 1) v += __shfl_xor(v, o);
    return v;
}
__device__ __forceinline__ float grp16_sum(float v) { v += __shfl_xor(v, 1); v += __shfl_xor(v, 2); v += __shfl_xor(v, 4); v += __shfl_xor(v, 8); return v; }
__device__ __forceinline__ float half_sum(float v) { v += __shfl_xor(v, 1); v += __shfl_xor(v, 2); v += __shfl_xor(v, 4); v += __shfl_xor(v, 8); v += __shfl_xor(v, 16); return v; }
__device__ __forceinline__ void unpack8(const v4u w, float* f) { f[0] = bflo(w.x); f[1] = bfhi(w.x); f[2] = bflo(w.y); f[3] = bfhi(w.y); f[4] = bflo(w.z); f[5] = bfhi(w.z); f[6] = bflo(w.w); f[7] = bfhi(w.w); }

#define CAS __attribute__((address_space(4)))
struct KIn { const CAS unsigned char* kp; __device__ __forceinline__ const float* operator[](int k) const { return *(const float* const CAS*)(kp + 8 * k); } };
struct Args {
    const float* in[28]; float* out; unsigned char* ws; int ph_lo, ph_hi, use_cg, pad;
};

__device__ __forceinline__ void rows_norm_bf16(const float* src, bf16* dst, int nrows, int gw, int ngw, int lane) {
    for (int m = gw; m < nrows; m += ngw) {
        const f32x4* xr = (const f32x4*)(src + (size_t)m * DM) + lane; f32x4 v[4]; float s = 0.f;
#pragma unroll
        for (int j = 0; j < 4; ++j) { v[j] = xr[64 * j]; s += (v[j].x * v[j].x + v[j].y * v[j].y) + (v[j].z * v[j].z + v[j].w * v[j].w); }
        const float rstd = 1.f / sqrtf(wave_sum(s) * (1.f / DM) + NORM_EPS);
        v2u* o8 = (v2u*)(dst + (size_t)m * DM) + lane;
#pragma unroll
        for (int j = 0; j < 4; ++j) { v2u w; w.x = pk2(v[j].x * rstd, v[j].y * rstd); w.y = pk2(v[j].z * rstd, v[j].w * rstd); o8[64 * j] = w; }
    }
}
__device__ __forceinline__ void rows_residual(const float* y, const float* xsrc, float* xdst, bf16* xb, const float* gain, int gw, int ngw, int lane) {
    f32x4 g[4];
#pragma unroll
    for (int j = 0; j < 4; ++j) g[j] = ((const f32x4*)gain)[lane + 64 * j];
    for (int m = gw; m < MTOK; m += ngw) {
        const f32x4* yr = (const f32x4*)(y + (size_t)m * DM) + lane; const f32x4* xr = (const f32x4*)(xsrc + (size_t)m * DM) + lane;
        f32x4 v[4], x[4]; float s = 0.f;
#pragma unroll
        for (int j = 0; j < 4; ++j) { v[j] = yr[64 * j]; x[j] = xr[64 * j]; s += (v[j].x * v[j].x + v[j].y * v[j].y) + (v[j].z * v[j].z + v[j].w * v[j].w); }
        const float rstd = 1.f / sqrtf(wave_sum(s) * (1.f / DM) + NORM_EPS);
        float s2 = 0.f;
#pragma unroll
        for (int j = 0; j < 4; ++j) { x[j] = x[j] + v[j] * rstd * g[j]; s2 += (x[j].x * x[j].x + x[j].y * x[j].y) + (x[j].z * x[j].z + x[j].w * x[j].w); }
        const float rstd2 = 1.f / sqrtf(wave_sum(s2) * (1.f / DM) + NORM_EPS);
        f32x4* xo = (f32x4*)(xdst + (size_t)m * DM) + lane; v2u* o8 = (v2u*)(xb + (size_t)m * DM) + lane;
#pragma unroll
        for (int j = 0; j < 4; ++j) { xo[64 * j] = x[j]; v2u w; w.x = pk2(x[j].x * rstd2, x[j].y * rstd2); w.y = pk2(x[j].z * rstd2, x[j].w * rstd2); o8[64 * j] = w; }
    }
}

__device__ __forceinline__ int inmap(int d) { return d < 768 ? d : (d < 3456 ? d + 8 : (d < 3712 ? d + 12 : (d < 3720 ? d - 2944 : (d < 3724 ? d - 256 : -1)))); }
template <bool MAP>
__device__ __forceinline__ void transpose_item(const float* W, int K, int N, bf16* WT, const float* gain, LAS float* scr, int item, int nblk, int lane) {
    const int kb = item / nblk, nb = item % nblk, k0 = 64 * kb, n0 = 32 * nb;
    const int nd = n0 + (lane & 31); const int src = MAP ? inmap(nd) : nd;
#pragma unroll 8
    for (int i = 0; i < 32; ++i) { const int kk = 2 * i + (lane >> 5); float v = 0.f; if (src >= 0) v = W[(size_t)(k0 + kk) * N + src]; if (gain) v *= gain[k0 + kk]; scr[kk * 33 + (lane & 31)] = v; }
    asm volatile("s_waitcnt lgkmcnt(0)" ::: "memory");
    const int c = lane & 7;
#pragma unroll
    for (int j = 0; j < 4; ++j) { const int n = (lane >> 3) + 8 * j; const LAS float* s = scr + (8 * c) * 33 + n;
        v4u o; o.x = pk2(s[0 * 33], s[1 * 33]); o.y = pk2(s[2 * 33], s[3 * 33]); o.z = pk2(s[4 * 33], s[5 * 33]); o.w = pk2(s[6 * 33], s[7 * 33]);
        *(v4u*)(WT + (size_t)(n0 + n) * K + k0 + 8 * c) = o; }
    asm volatile("s_waitcnt lgkmcnt(0)" ::: "memory");
}
__device__ __forceinline__ void phase_convert(const KIn ain, unsigned char* ws, int l, LAS unsigned char* lds, int gw, int ngw, int wave, int lane) {
    LAS float* scr = (LAS float*)(lds + wave * 16384);
        const float* w_in = ain[4] + (size_t)l * DM * NIN; const float* w_out = ain[21] + (size_t)l * DM * DM; const float* wq = ain[25] + (size_t)l * DM * DM;
    const float* wkv = ain[26] + (size_t)l * DM * 2 * DM; const float* wo = ain[27] + (size_t)l * DM * DM;
    const float* g_pre = ain[2] + l * DM; const float* g_xpre = ain[23] + l * DM; const float* g_mem = ain[22];
    constexpr int I_IN = 16 * (NINP / 32), I_SQ = 16 * (DM / 32), I_KV = 16 * (2 * DM / 32);
    constexpr int NITEMS = I_IN + 3 * I_SQ + I_KV;
    for (int it = gw; it < NITEMS; it += ngw) {
        int r = it;
        if (r < I_IN) { transpose_item<true>(w_in, DM, NIN, (bf16*)(ws + WS_WIN), g_pre, scr, r, NINP / 32, lane); continue; } r -= I_IN;
        if (r < I_SQ) { transpose_item<false>(w_out, DM, DM, (bf16*)(ws + WS_WOUT), nullptr, scr, r, DM / 32, lane); continue; } r -= I_SQ;
        if (r < I_SQ) { transpose_item<false>(wq, DM, DM, (bf16*)(ws + WS_WQ), g_xpre, scr, r, DM / 32, lane); continue; } r -= I_SQ;
        if (r < I_SQ) { transpose_item<false>(wo, DM, DM, (bf16*)(ws + WS_WO), nullptr, scr, r, DM / 32, lane); continue; } r -= I_SQ;
        transpose_item<false>(wkv, DM, 2 * DM, (bf16*)(ws + WS_WKV), g_mem, scr, r, 2 * DM / 32, lane);
    }
    const float* b_in = ain[5] + (size_t)l * NIN; float* bp = (float*)(ws + WS_BIASP);
    for (int d = gw * 64 + lane; d < NINP; d += ngw * 64) { const int s = inmap(d); bp[d] = s >= 0 ? b_in[s] : 0.f; }
}

__device__ __forceinline__ void prep_cumsum(const float* gatesT, float* cum, int gw, int ngw, int lane) {
    for (int seq = gw; seq < 64; seq += ngw) {
        const int g = seq >> 3, b = seq & 7; const float* src = gatesT + (size_t)(4 + g) * MTOK + (size_t)b * SEQ + lane * 32; float* dst = cum + (size_t)g * MTOK + (size_t)b * SEQ + lane * 32;
        float v[32]; float run = 0.f;
#pragma unroll
        for (int i = 0; i < 8; ++i) { const f32x4 x = ((const f32x4*)src)[i]; v[4 * i] = logsigmoid_f(x.x); v[4 * i + 1] = logsigmoid_f(x.y); v[4 * i + 2] = logsigmoid_f(x.z); v[4 * i + 3] = logsigmoid_f(x.w); }
#pragma unroll
        for (int i = 0; i < 32; ++i) { run += v[i]; v[i] = run; }
        float tot = run;
#pragma unroll
        for (int o = 1; o < 64; o <<= 1) { const float t = __shfl_up(tot, o); if (lane >= o) tot += t; }
        const float excl = tot - run;
#pragma unroll
        for (int i = 0; i < 8; ++i) { f32x4 x; x.x = v[4 * i] + excl; x.y = v[4 * i + 1] + excl; x.z = v[4 * i + 2] + excl; x.w = v[4 * i + 3] + excl; ((f32x4*)dst)[i] = x; }
    }
}
__device__ __forceinline__ void prep_foxnorm(bf16* proj, const float* qkg, int gw, int ngw, int lane) {
    const int e0 = (lane & 15) * 4;
    float g0[4], g1[4];
#pragma unroll
    for (int e = 0; e < 4; ++e) { g0[e] = qkg[e0 + e] * 0.125f; g1[e] = qkg[64 + e0 + e]; }
    for (int m = gw; m < MTOK; m += ngw) {
        bf16* row = proj + (size_t)m * PP;
        v2u* qp = (v2u*)(row + P_DQ + lane * 4); v2u* kp = (v2u*)(row + P_DK + lane * 4);
        const v2u qw = *qp, kw = *kp;
        float q[4] = {bflo(qw.x), bfhi(qw.x), bflo(qw.y), bfhi(qw.y)}, k[4] = {bflo(kw.x), bfhi(kw.x), bflo(kw.y), bfhi(kw.y)};
        const float sq = grp16_sum(q[0] * q[0] + q[1] * q[1] + q[2] * q[2] + q[3] * q[3]), sk = grp16_sum(k[0] * k[0] + k[1] * k[1] + k[2] * k[2] + k[3] * k[3]);
        const float rq = 1.f / sqrtf(sq * (1.f / 64.f) + NORM_EPS), rk = 1.f / sqrtf(sk * (1.f / 64.f) + NORM_EPS);
        v2u o; o.x = pk2(q[0] * rq * g0[0], q[1] * rq * g0[1]); o.y = pk2(q[2] * rq * g0[2], q[3] * rq * g0[3]); *qp = o;
        o.x = pk2(k[0] * rk * g1[0], k[1] * rk * g1[1]); o.y = pk2(k[2] * rk * g1[2], k[3] * rk * g1[3]); *kp = o;
    }
}
__device__ __forceinline__ void prep_rwkv(const KIn ain, unsigned char* ws, int l, const bf16* proj, LAS unsigned char* lds, int bid, int nb, int tid) {
        LAS float* lo = (LAS float*)lds;
    const float* mu = ain[10] + l * 896; const float* w0 = ain[11] + l * 256; const float* w2 = ain[12] + (size_t)l * 64 * 256; const float* a0 = ain[13] + l * 256; const float* a2 = ain[14] + (size_t)l * 64 * 256;
    const float* key_k = ain[15] + l * 256; const float* key_a = ain[16] + l * 256; const float* bonus_u = ain[17] + l * 256;
    bf16* rr = (bf16*)(ws + WS_RR); bf16* rk = (bf16*)(ws + WS_RK); bf16* rv = (bf16*)(ws + WS_RV); bf16* rkk = (bf16*)(ws + WS_RKK); bf16* rb = (bf16*)(ws + WS_RB);
    float* rw = (float*)(ws + WS_RW); float* sbon = (float*)(ws + WS_SBON);
    const int c = tid & 255, tg = tid >> 8, lane = tid & 63;
    const float mur = mu[c], muk = mu[256 + c], muv = mu[512 + c], w0c = w0[c], a0c = a0[c], kkc = key_k[c], kac = key_a[c], buc = bonus_u[c];
    for (int it = bid; it < MTOK / 16; it += nb) {
        const int m0 = it * 16;
        __syncthreads();
#pragma unroll
        for (int i = 0; i < 4; ++i) { const int idx = tid + 512 * i, tok = idx >> 7, j = idx & 127; const int m = m0 + tok; const int t = m & (SEQ - 1);
            const float cur = bf1(proj[(size_t)m * PP + P_CW + j]); const float prev = t > 0 ? bf1(proj[(size_t)(m - 1) * PP + P_CW + j]) : 0.f;
            float v = cur + mu[768 + j] * (prev - cur); if (j < 64) v = tanhf(v); lo[tok * 128 + j] = v; }
        __syncthreads();
        float accw[8], acca[8];
#pragma unroll
        for (int i = 0; i < 8; ++i) { accw[i] = 0.f; acca[i] = 0.f; }
        for (int j = 0; j < 64; ++j) { const float w2v = w2[j * 256 + c], a2v = a2[j * 256 + c];
#pragma unroll
            for (int i = 0; i < 8; ++i) { accw[i] += lo[(tg * 8 + i) * 128 + j] * w2v; acca[i] += lo[(tg * 8 + i) * 128 + 64 + j] * a2v; } }
#pragma unroll
        for (int i = 0; i < 8; ++i) { const int m = m0 + tg * 8 + i; const int t = m & (SEQ - 1); const bf16* row = proj + (size_t)m * PP; const bf16* prow = row - PP;
            const float cr = bf1(row[P_CR + c]), ck = bf1(row[P_CK + c]), cv = bf1(row[P_CV + c]);
            const float pr = t > 0 ? bf1(prow[P_CR + c]) : 0.f, pk = t > 0 ? bf1(prow[P_CK + c]) : 0.f, pv = t > 0 ? bf1(prow[P_CV + c]) : 0.f;
            const float r = cr + mur * (pr - cr), k = ck + muk * (pk - ck), v = cv + muv * (pv - cv);
            const float wl = -softplus_f(-(w0c + accw[i])) - 0.5f; const float decay = __expf(-__expf(wl));
            const float av = sigmoid_f(a0c + acca[i]);
            const float kkv = k * kkc; const float ss = wave_sum(kkv * kkv); const float kkn = kkv / fmaxf(sqrtf(ss), 1e-12f);
            const float k2 = k * (1.f + (av - 1.f) * kac); const float bb = kkn * av;
            const float sb = wave_sum(r * k2 * buc);
            const size_t o = (size_t)m * 256 + c;
            rr[o] = (bf16)f2bf(r); rk[o] = (bf16)f2bf(k2); rv[o] = (bf16)f2bf(v); rkk[o] = (bf16)f2bf(kkn); rb[o] = (bf16)f2bf(bb); rw[o] = decay;
            if (lane == 0) sbon[(size_t)m * 4 + (c >> 6)] = sb; }
    }
}
__device__ __forceinline__ void prep_pool(const KIn ain, unsigned char* ws, int l, const bf16* proj, bf16* ybuf, LAS unsigned char* lds, int bid, int nb, int tid) {
    LAS float* pl = (LAS float*)(lds + 16384);
    const float* pw = ain[8] + (size_t)l * 4 * 64 * 64; const float* ps = ain[9] + l * 256;
    const int c = tid & 255, tg = tid >> 8, g = c >> 6, d = c & 63; const int win = 2 << g; const float psc = ps[c];
    for (int it = bid; it < MTOK / 16; it += nb) {
        const int m0 = it * 16 + tg * 8; const int t0 = m0 & (SEQ - 1);
        __syncthreads();
        float vals[23];
#pragma unroll
        for (int i = 0; i < 23; ++i) { const int t = t0 - 15 + i; vals[i] = t >= 0 ? bf1(proj[(size_t)(m0 - 15 + i) * PP + P_BX + c]) : 0.f; }
#pragma unroll
        for (int i = 0; i < 8; ++i) { float s = 0.f;
#pragma unroll
            for (int j = 0; j < 16; ++j) if (j < win) s += vals[15 + i - j];
            const int cnt = min(t0 + i + 1, win); pl[(tg * 8 + i) * 256 + c] = s / (float)cnt - vals[15 + i]; }
        __syncthreads();
        float acc[8];
#pragma unroll
        for (int i = 0; i < 8; ++i) acc[i] = 0.f;
        for (int cc = 0; cc < 64; ++cc) { const float wv = pw[(g * 64 + cc) * 64 + d];
#pragma unroll
            for (int i = 0; i < 8; ++i) acc[i] += pl[(tg * 8 + i) * 256 + g * 64 + cc] * wv; }
#pragma unroll
        for (int i = 0; i < 8; ++i) { const int m = m0 + i; const float z = bf1(proj[(size_t)m * PP + P_BZ + c]); ybuf[(size_t)m * DM + 256 + c] = (bf16)f2bf(acc[i] * psc * silu_f(z)); }
    }
}

__device__ __forceinline__ void mix_mlstm_item(const KIn ain, unsigned char* ws, int l, const bf16* proj, bf16* ybuf, LAS unsigned char* lds, int bh, int qb, int tid) {
        const int b = bh >> 2, h = bh & 3; const int t = qb * 512 + tid; const size_t m = (size_t)b * SEQ + t;
    const float* cw = ain[6] + (size_t)l * 4 * 512;
    const float* gatesT = (const float*)(ws + WS_GATES); const float* cumA = (const float*)(ws + WS_CUM) + (size_t)h * MTOK;
    LAS float* Ks = (LAS float*)lds; LAS float* Vs = (LAS float*)(lds + 16384); LAS float* gs = (LAS float*)(lds + 32768);
    float q[64], acc[64];
#pragma unroll
    for (int d8 = 0; d8 < 8; ++d8) { float s[8];
#pragma unroll
        for (int e = 0; e < 8; ++e) s[e] = 0.f;
#pragma unroll
        for (int j = 0; j < 4; ++j) { const int tt = t - 3 + j; if (tt >= 0) { const v4u w = *(const v4u*)(proj + (m - 3 + j) * PP + P_AQ + h * 64 + d8 * 8); float f[8]; unpack8(w, f);
#pragma unroll
                for (int e = 0; e < 8; ++e) s[e] += f[e] * cw[j * 512 + h * 64 + d8 * 8 + e]; } }
#pragma unroll
        for (int e = 0; e < 8; ++e) q[d8 * 8 + e] = silu_f(s[e]); }
#pragma unroll
    for (int d = 0; d < 64; ++d) acc[d] = 0.f;
    float den = 0.f; const float bt = cumA[m];
    const int skey = tid >> 3, sd0 = (tid & 7) * 8;
    const int nt = (qb * 512 + 512) / 64;
    for (int kt = 0; kt < nt; ++kt) {
        __syncthreads();
        { const int s = kt * 64 + skey; const size_t ms = (size_t)b * SEQ + s; float sk[8];
#pragma unroll
            for (int e = 0; e < 8; ++e) sk[e] = 0.f;
#pragma unroll
            for (int j = 0; j < 4; ++j) { const int tt = s - 3 + j; if (tt >= 0) { const v4u w = *(const v4u*)(proj + (ms - 3 + j) * PP + P_AK + h * 64 + sd0); float f[8]; unpack8(w, f);
#pragma unroll
                    for (int e = 0; e < 8; ++e) sk[e] += f[e] * cw[j * 512 + 256 + h * 64 + sd0 + e]; } }
#pragma unroll
            for (int e = 0; e < 8; ++e) Ks[skey * 64 + sd0 + e] = silu_f(sk[e]) * 0.125f;
            const v4u w = *(const v4u*)(proj + ms * PP + P_AV + h * 64 + sd0); float f[8]; unpack8(w, f);
#pragma unroll
            for (int e = 0; e < 8; ++e) Vs[skey * 64 + sd0 + e] = f[e];
            if (tid < 64) { const size_t mk = (size_t)b * SEQ + kt * 64 + tid; gs[tid] = gatesT[(size_t)h * MTOK + mk] - cumA[mk]; } }
        __syncthreads();
        const int kmax = min(64, t - kt * 64 + 1);
        for (int key = 0; key < kmax; ++key) {
            float dot = 0.f;
#pragma unroll
            for (int d4 = 0; d4 < 16; ++d4) { const f32x4 kv = *(const LAS f32x4*)(Ks + key * 64 + d4 * 4); dot += q[d4 * 4] * kv.x + q[d4 * 4 + 1] * kv.y + q[d4 * 4 + 2] * kv.z + q[d4 * 4 + 3] * kv.w; }
            const float w = dot * __expf(bt + gs[key]); den += w;
#pragma unroll
            for (int d4 = 0; d4 < 16; ++d4) { const f32x4 vv = *(const LAS f32x4*)(Vs + key * 64 + d4 * 4); acc[d4 * 4] += w * vv.x; acc[d4 * 4 + 1] += w * vv.y; acc[d4 * 4 + 2] += w * vv.z; acc[d4 * 4 + 3] += w * vv.w; }
        }
    }
    const float inv = 1.f / fmaxf(fabsf(den), 1.f); float ss = 0.f;
#pragma unroll
    for (int d = 0; d < 64; ++d) { acc[d] *= inv; ss += acc[d] * acc[d]; }
    const float rs = 1.f / sqrtf(ss * (1.f / 64.f) + NORM_EPS);
    const float* ng = ain[7] + l * 256 + h * 64;
#pragma unroll
    for (int d8 = 0; d8 < 8; ++d8) { const v4u zw = *(const v4u*)(proj + m * PP + P_AZ + h * 64 + d8 * 8); float z[8]; unpack8(zw, z); v4u o;
        float y[8];
#pragma unroll
        for (int e = 0; e < 8; ++e) y[e] = acc[d8 * 8 + e] * rs * ng[d8 * 8 + e] * silu_f(z[e]);
        o.x = pk2(y[0], y[1]); o.y = pk2(y[2], y[3]); o.z = pk2(y[4], y[5]); o.w = pk2(y[6], y[7]);
        *(v4u*)(ybuf + m * DM + 0 + h * 64 + d8 * 8) = o; }
}
__device__ __forceinline__ void mix_fox_item(const KIn ain, unsigned char* ws, int l, const bf16* proj, bf16* ybuf, LAS unsigned char* lds, int bh, int qb, int tid) {
        const int b = bh >> 2, h = bh & 3; const int t = qb * 512 + tid; const size_t m = (size_t)b * SEQ + t;
    const float* cumD = (const float*)(ws + WS_CUM) + (size_t)(4 + h) * MTOK;
    LAS float* Ks = (LAS float*)lds; LAS float* Vs = (LAS float*)(lds + 16384); LAS float* gs = (LAS float*)(lds + 32768);
    float q[64], acc[64];
#pragma unroll
    for (int d8 = 0; d8 < 8; ++d8) { const v4u w = *(const v4u*)(proj + m * PP + P_DQ + h * 64 + d8 * 8); unpack8(w, q + d8 * 8); }
#pragma unroll
    for (int d = 0; d < 64; ++d) acc[d] = 0.f;
    float mx = -1e30f, lsum = 0.f; const float ft = cumD[m];
    const int skey = tid >> 3, sd0 = (tid & 7) * 8;
    const int nt = (qb * 512 + 512) / 64;
    for (int kt = 0; kt < nt; ++kt) {
        __syncthreads();
        { const int s = kt * 64 + skey; const size_t ms = (size_t)b * SEQ + s;
            const v4u kw = *(const v4u*)(proj + ms * PP + P_DK + h * 64 + sd0); float f[8]; unpack8(kw, f);
#pragma unroll
            for (int e = 0; e < 8; ++e) Ks[skey * 64 + sd0 + e] = f[e];
            const v4u w = *(const v4u*)(proj + ms * PP + P_DV + h * 64 + sd0); unpack8(w, f);
#pragma unroll
            for (int e = 0; e < 8; ++e) Vs[skey * 64 + sd0 + e] = f[e];
            if (tid < 64) gs[tid] = cumD[(size_t)b * SEQ + kt * 64 + tid]; }
        __syncthreads();
        const int kmax = min(64, t - kt * 64 + 1);
        for (int key = 0; key < kmax; ++key) {
            float dot = 0.f;
#pragma unroll
            for (int d4 = 0; d4 < 16; ++d4) { const f32x4 kv = *(const LAS f32x4*)(Ks + key * 64 + d4 * 4); dot += q[d4 * 4] * kv.x + q[d4 * 4 + 1] * kv.y + q[d4 * 4 + 2] * kv.z + q[d4 * 4 + 3] * kv.w; }
            const float sc = dot + ft - gs[key];
            if (sc > mx) { const float f = __expf(mx - sc); lsum *= f;
#pragma unroll
                for (int d = 0; d < 64; ++d) acc[d] *= f;
                mx = sc; }
            const float p = __expf(sc - mx); lsum += p;
#pragma unroll
            for (int d4 = 0; d4 < 16; ++d4) { const f32x4 vv = *(const LAS f32x4*)(Vs + key * 64 + d4 * 4); acc[d4 * 4] += p * vv.x; acc[d4 * 4 + 1] += p * vv.y; acc[d4 * 4 + 2] += p * vv.z; acc[d4 * 4 + 3] += p * vv.w; }
        }
    }
    const float inv = 1.f / lsum;
#pragma unroll
    for (int d8 = 0; d8 < 8; ++d8) { const v4u zw = *(const v4u*)(proj + m * PP + P_DZ + h * 64 + d8 * 8); float z[8]; unpack8(zw, z); v4u o;
        float y[8];
#pragma unroll
        for (int e = 0; e < 8; ++e) y[e] = acc[d8 * 8 + e] * inv * silu_f(z[e]);
        o.x = pk2(y[0], y[1]); o.y = pk2(y[2], y[3]); o.z = pk2(y[4], y[5]); o.w = pk2(y[6], y[7]);
        *(v4u*)(ybuf + m * DM + 768 + h * 64 + d8 * 8) = o; }
}
__device__ __forceinline__ void mix_rwkv_item(const KIn ain, unsigned char* ws, int bh, int rg, int tid) {
        const bf16* rr = (const bf16*)(ws + WS_RR); const bf16* rk = (const bf16*)(ws + WS_RK); const bf16* rv = (const bf16*)(ws + WS_RV); const bf16* rkk = (const bf16*)(ws + WS_RKK); const bf16* rb = (const bf16*)(ws + WS_RB);
    const float* rw = (const float*)(ws + WS_RW); float* yraw = (float*)(ws + WS_YRAW);
    const int b = bh >> 2, h = bh & 3; const int wave = tid >> 6, lane = tid & 63, j = lane & 31; const int row = rg * 16 + wave * 2 + (lane >> 5);
    const size_t base0 = ((size_t)b * SEQ) * 256 + h * 64;
    float S0 = 0.f, S1 = 0.f;
#pragma unroll 4
    for (int t = 0; t < SEQ; ++t) {
        const size_t base = base0 + (size_t)t * 256;
        const f32x2 w = *(const f32x2*)(rw + base + 2 * j);
        const unsigned kkw = *(const unsigned*)(rkk + base + 2 * j), bw = *(const unsigned*)(rb + base + 2 * j), kw = *(const unsigned*)(rk + base + 2 * j), rw_ = *(const unsigned*)(rr + base + 2 * j);
        const float vv = bf1(rv[base + row]);
        const float sa = -half_sum(S0 * bflo(kkw) + S1 * bfhi(kkw));
        S0 = S0 * w.x + sa * bflo(bw) + vv * bflo(kw); S1 = S1 * w.y + sa * bfhi(bw) + vv * bfhi(kw);
        const float y = half_sum(S0 * bflo(rw_) + S1 * bfhi(rw_));
        if (j == 0) yraw[base + row] = y;
    }
}
__device__ __forceinline__ void phase_mix(const KIn ain, unsigned char* ws, int l, const bf16* proj, bf16* ybuf, LAS unsigned char* lds, int bid, int nb, int tid) {
    for (int it = bid; it < 384; it += nb) {
        if (it < 128) { mix_rwkv_item(ain, ws, it >> 2, it & 3, tid); continue; }
        const int j = it - 128; const int qb = 3 - (j >> 6), rest = j & 63, bh = rest >> 1;
        if (rest & 1) mix_fox_item(ain, ws, l, proj, ybuf, lds, bh, qb, tid); else mix_mlstm_item(ain, ws, l, proj, ybuf, lds, bh, qb, tid);
    }
}
__device__ __forceinline__ void phase_rwkv_post(const KIn ain, unsigned char* ws, int l, const bf16* proj, bf16* ybuf, int gw, int ngw, int lane) {
        const float* yraw = (const float*)(ws + WS_YRAW); const float* sbon = (const float*)(ws + WS_SBON); const bf16* rv = (const bf16*)(ws + WS_RV);
    const f32x4 gg = ((const f32x4*)(ain[18] + l * 256))[lane], gb = ((const f32x4*)(ain[19] + l * 256))[lane];
    for (int m = gw; m < MTOK; m += ngw) {
        const f32x4 y = ((const f32x4*)(yraw + (size_t)m * 256))[lane];
        const float mean = grp16_sum((y.x + y.y) + (y.z + y.w)) * (1.f / 64.f);
        const f32x4 dlt = y - mean; const float var = grp16_sum((dlt.x * dlt.x + dlt.y * dlt.y) + (dlt.z * dlt.z + dlt.w * dlt.w)) * (1.f / 64.f);
        const float rs = 1.f / sqrtf(var + GN_EPS); const float sb = sbon[(size_t)m * 4 + (lane >> 4)];
        const v2u vw = *(const v2u*)(rv + (size_t)m * 256 + lane * 4); const v2u zw = *(const v2u*)(proj + (size_t)m * PP + P_CZ + lane * 4);
        const float o0 = (dlt.x * rs * gg.x + gb.x + sb * bflo(vw.x)) * silu_f(bflo(zw.x)), o1 = (dlt.y * rs * gg.y + gb.y + sb * bfhi(vw.x)) * silu_f(bfhi(zw.x));
        const float o2 = (dlt.z * rs * gg.z + gb.z + sb * bflo(vw.y)) * silu_f(bflo(zw.y)), o3 = (dlt.w * rs * gg.w + gb.w + sb * bfhi(vw.y)) * silu_f(bfhi(zw.y));
        v2u o; o.x = pk2(o0, o1); o.y = pk2(o2, o3); *(v2u*)(ybuf + (size_t)m * DM + 512 + lane * 4) = o;
    }
}
__device__ __forceinline__ void phase_xattn(const KIn ain, unsigned char* ws, const bf16* qbuf, bf16* obuf, LAS unsigned char* lds, int bid, int nb, int tid) {
    const bf16* kv = (const bf16*)(ws + WS_KV);
    LAS bf16* Ks = (LAS bf16*)lds; LAS bf16* Vs = (LAS bf16*)(lds + 32768);
    const int qi = tid >> 2, part = tid & 3;
    for (int it = bid; it < 512; it += nb) {
        const int qb = it & 15, h = (it >> 4) & 3, b = it >> 6; const size_t m = (size_t)b * SEQ + qb * 128 + qi;
        float q[64], acc[64];
#pragma unroll
        for (int d8 = 0; d8 < 8; ++d8) { const v4u w = *(const v4u*)(qbuf + m * DM + h * 256 + part * 64 + d8 * 8); unpack8(w, q + d8 * 8); }
#pragma unroll
        for (int d = 0; d < 64; ++d) acc[d] = 0.f;
        float mx = -1e30f, lsum = 0.f;
        for (int kt = 0; kt < 4; ++kt) {
            __syncthreads();
#pragma unroll
            for (int i = 0; i < 4; ++i) { const int idx = tid + 512 * i, key = idx >> 5, c8 = (idx & 31) * 8; const size_t mr = (size_t)b * NMEM + kt * 64 + key;
                *(LAS v4u*)(Ks + key * 256 + c8) = *(const v4u*)(kv + mr * 2048 + h * 256 + c8); *(LAS v4u*)(Vs + key * 256 + c8) = *(const v4u*)(kv + mr * 2048 + 1024 + h * 256 + c8); }
            __syncthreads();
            for (int key = 0; key < 64; ++key) {
                float dot = 0.f;
#pragma unroll
                for (int d8 = 0; d8 < 8; ++d8) { const v4u w = *(const LAS v4u*)(Ks + key * 256 + part * 64 + d8 * 8); float f[8]; unpack8(w, f);
#pragma unroll
                    for (int e = 0; e < 8; ++e) dot += q[d8 * 8 + e] * f[e]; }
                dot += __shfl_xor(dot, 1); dot += __shfl_xor(dot, 2);
                const float sc = dot * 0.0625f;
                if (sc > mx) { const float f = __expf(mx - sc); lsum *= f;
#pragma unroll
                    for (int d = 0; d < 64; ++d) acc[d] *= f;
                    mx = sc; }
                const float p = __expf(sc - mx); lsum += p;
#pragma unroll
                for (int d8 = 0; d8 < 8; ++d8) { const v4u w = *(const LAS v4u*)(Vs + key * 256 + part * 64 + d8 * 8); float f[8]; unpack8(w, f);
#pragma unroll
                    for (int e = 0; e < 8; ++e) acc[d8 * 8 + e] += p * f[e]; }
            }
        }
        const float inv = 1.f / lsum;
#pragma unroll
        for (int d8 = 0; d8 < 8; ++d8) { v4u o; o.x = pk2(acc[d8 * 8] * inv, acc[d8 * 8 + 1] * inv); o.y = pk2(acc[d8 * 8 + 2] * inv, acc[d8 * 8 + 3] * inv); o.z = pk2(acc[d8 * 8 + 4] * inv, acc[d8 * 8 + 5] * inv); o.w = pk2(acc[d8 * 8 + 6] * inv, acc[d8 * 8 + 7] * inv);
            *(v4u*)(obuf + m * DM + h * 256 + part * 64 + d8 * 8) = o; }
    }
}

constexpr int PH_PER_LAYER = 12, N_PHASES = 1 + DEPTH * PH_PER_LAYER;
__global__ void __launch_bounds__(NTHR, 2) mk_fwd(Args args) {
    extern __shared__ __attribute__((aligned(16))) unsigned char lds_raw[];
    LAS unsigned char* lds = (LAS unsigned char*)lds_raw;
    unsigned char* ws0 = args.ws;
    volatile LAS unsigned* MISC = (volatile LAS unsigned*)(lds + MISC_OFF);
    for (int u = threadIdx.x; u < (LDS_BYTES - LDSCTL_OFF) / 4; u += NTHR) ((LAS unsigned*)(lds + LDSCTL_OFF))[u] = 0u;
    __syncthreads();
    XcdBarrier bar; bar.bar = (unsigned*)(ws0 + WS_CTL) + CW_BAR; bar.x = 0; bar.st = nullptr;
    const bool multi = (args.ph_hi - args.ph_lo) > 1;
    if (multi && !args.use_cg) bar = xcd_barrier_post((unsigned*)(ws0 + WS_CTL) + CW_BAR, MISC + 8);
    float* xout = args.out;
    for (int ph = args.ph_lo; ph < args.ph_hi; ++ph) {
        int tid = threadIdx.x; asm volatile("" : "+v"(tid));
        int bid = blockIdx.x, G = gridDim.x; unsigned char* ws = ws0; asm volatile("" : "+s"(bid), "+s"(G), "+s"(ws));
        KIn ain; ain.kp = (const CAS unsigned char*)__builtin_amdgcn_kernarg_segment_ptr(); asm volatile("" : "+s"(ain.kp));
        const int lane = tid & 63, wave = __builtin_amdgcn_readfirstlane(tid >> 6); const int gw = bid * NWAVES + wave, ngw = G * NWAVES;
        bf16* bufA = (bf16*)(ws + WS_BUFA); bf16* proj = (bf16*)(ws + WS_BUFP); float* ytmp = (float*)(ws + WS_BUFP); bf16* qbuf = (bf16*)(ws + WS_BUFP + 64 * MiB);
        if (ph == 0) {
            rows_norm_bf16(ain[0], bufA, MTOK, gw, ngw, lane);
            rows_norm_bf16(ain[1], (bf16*)(ws + WS_MEMN), MMEM, gw, ngw, lane);
        } else {
            const int l = (ph - 1) / PH_PER_LAYER, s = (ph - 1) % PH_PER_LAYER;
#ifndef PHMASK
#define PHMASK 0xFFF
#endif
            switch (s) {
            case 0: if (!((PHMASK >> 0) & 1)) break; phase_convert(ain, ws, l, lds, gw, ngw, wave, lane); break;
            case 1: if (!((PHMASK >> 1) & 1)) break; { pg8::Gemm g{(const bf16*)(ws + WS_MEMN), (const bf16*)(ws + WS_WKV), MMEM, 2 * DM, DM}; pg8::StaticOrder S; S.init(MMEM, 2 * DM, G, bid);
                      pg8::EpiB16 E{(bf16*)(ws + WS_KV), 2 * DM}; pg8::gemm_phase<pg8::EpiB16, pg8::StaticOrder, true, true>(lds, g, S, E); } break;
            case 2: if (!((PHMASK >> 2) & 1)) break; { pg8::Gemm g{bufA, (const bf16*)(ws + WS_WIN), MTOK, NINP, DM}; pg8::StaticOrder S; S.init(MTOK, NINP, G, bid);
                      pg8::EpiProj E{proj, PP, PP, (const float*)(ws + WS_BIASP), (float*)(ws + WS_GATES), P_G, MTOK}; pg8::gemm_phase<pg8::EpiProj, pg8::StaticOrder, true, true>(lds, g, S, E); } break;
            case 3: if (!((PHMASK >> 3) & 1)) break; prep_cumsum((const float*)(ws + WS_GATES), (float*)(ws + WS_CUM), gw, ngw, lane);
                    prep_foxnorm(proj, ain[20] + l * 128, gw, ngw, lane);
                    prep_rwkv(ain, ws, l, proj, lds, bid, G, tid);
                    prep_pool(ain, ws, l, proj, bufA, lds, bid, G, tid); break;
            case 4: if (!((PHMASK >> 4) & 1)) break; phase_mix(ain, ws, l, proj, bufA, lds, bid, G, tid); break;
            case 5: if (!((PHMASK >> 5) & 1)) break; phase_rwkv_post(ain, ws, l, proj, bufA, gw, ngw, lane); break;
            case 6: if (!((PHMASK >> 6) & 1)) break; { pg8::Gemm g{bufA, (const bf16*)(ws + WS_WOUT), MTOK, DM, DM}; pg8::StaticOrder S; S.init(MTOK, DM, G, bid);
                      pg8::EpiF32 E{ytmp, DM}; pg8::gemm_phase<pg8::EpiF32, pg8::StaticOrder, true, true>(lds, g, S, E); } break;
            case 7: if (!((PHMASK >> 7) & 1)) break; rows_residual(ytmp, l == 0 ? ain[0] : xout, xout, bufA, ain[3] + l * DM, gw, ngw, lane); break;
            case 8: if (!((PHMASK >> 8) & 1)) break; { pg8::Gemm g{bufA, (const bf16*)(ws + WS_WQ), MTOK, DM, DM}; pg8::StaticOrder S; S.init(MTOK, DM, G, bid);
                      pg8::EpiB16 E{qbuf, DM}; pg8::gemm_phase<pg8::EpiB16, pg8::StaticOrder, true, true>(lds, g, S, E); } break;
            case 9: if (!((PHMASK >> 9) & 1)) break; phase_xattn(ain, ws, qbuf, bufA, lds, bid, G, tid); break;
            case 10: if (!((PHMASK >> 10) & 1)) break; { pg8::Gemm g{bufA, (const bf16*)(ws + WS_WO), MTOK, DM, DM}; pg8::StaticOrder S; S.init(MTOK, DM, G, bid);
                       pg8::EpiF32 E{ytmp, DM}; pg8::gemm_phase<pg8::EpiF32, pg8::StaticOrder, true, true>(lds, g, S, E); } break;
            case 11: if (!((PHMASK >> 11) & 1)) break; rows_residual(ytmp, xout, xout, bufA, ain[24] + l * DM, gw, ngw, lane); break;
            }
        }
        if (ph + 1 < args.ph_hi) { if (args.use_cg) { cg::this_grid().sync(); } else { xcd_barrier(bar); } }
    }
}

#ifndef MK_SPLIT
#define MK_SPLIT 1
#endif
extern "C" void kernel_launch(void* const* d_in, const int* in_sizes, int n_in, void* d_out, int out_size, void* d_ws, size_t ws_size, hipStream_t stream) {
    static int grid = 0;
    if (grid == 0) {
        if (n_in != 28 || out_size != MTOK * DM || ws_size < WS_END) { fprintf(stderr, "kernel_launch: unexpected shapes (n_in %d out %d ws %zu)\n", n_in, out_size, ws_size); grid = -1; return; }
        int dev = 0, cus = 0, per_cu = 0;
        hipGetDevice(&dev); hipDeviceGetAttribute(&cus, hipDeviceAttributeMultiprocessorCount, dev);
        hipFuncSetAttribute((const void*)mk_fwd, hipFuncAttributeMaxDynamicSharedMemorySize, LDS_BYTES);
        hipOccupancyMaxActiveBlocksPerMultiprocessor(&per_cu, (const void*)mk_fwd, NTHR, LDS_BYTES);
        (void)hipGetLastError();
        if (per_cu < 1) { fprintf(stderr, "kernel_launch: occupancy query says %d blocks/CU\n", per_cu); }
        grid = cus;
    }
    if (grid < 0) return;
    hipMemsetAsync((char*)d_ws + WS_CTL, 0, CTL_ZERO_BYTES, stream);
    Args a{};
    for (int i = 0; i < 28; ++i) a.in[i] = (const float*)d_in[i];
    a.out = (float*)d_out; a.ws = (unsigned char*)d_ws; a.use_cg = 0; a.pad = 0;
#if MK_SPLIT
    for (int ph = 0; ph < N_PHASES; ++ph) { a.ph_lo = ph; a.ph_hi = ph + 1; hipLaunchKernelGGL(mk_fwd, dim3(grid), dim3(NTHR), LDS_BYTES, stream, a); }
#else
    a.ph_lo = 0; a.ph_hi = N_PHASES;
    void* kargs[] = {&a};
    hipError_t e = hipLaunchCooperativeKernel((const void*)mk_fwd, dim3(grid), dim3(NTHR), kargs, LDS_BYTES, stream);
    if (e != hipSuccess) fprintf(stderr, "cooperative launch failed: %s (grid %d)\n", hipGetErrorString(e), grid);
#endif
}
```

```cpp
#include <hip/hip_runtime.h>
#include <hip/hip_cooperative_groups.h>
#include <cstdio>
#include <cstdint>
namespace cg = cooperative_groups;
#define GAS __attribute__((address_space(1)))
#define LAS __attribute__((address_space(3)))
namespace pg8 {
#define PG8_LAS __attribute__((address_space(3)))
typedef unsigned short bf16_t;
typedef short bf16x8 __attribute__((ext_vector_type(8)));
typedef float f32x4 __attribute__((ext_vector_type(4)));
typedef unsigned u32x4 __attribute__((ext_vector_type(4)));
constexpr int BM = 256, BK = 64, HALF = 128, HTB = HALF * BK * 2  , STAGE_BYTES = 8 * HTB, NXCD = 8, WGM = 8;

__host__ __device__ __forceinline__ int lds_byte(int r, int c) { const int st = (r >> 4) * 2 + (c >> 5), rr = r & 15, cc = c & 31, ob = rr * 64 + cc * 2; return st * 1024 + (ob ^ (((ob >> 9) & 1) << 5)); }
__host__ __device__ __forceinline__ void stage_rc(int b, int& R, int& C) { const int st = b / 1024, sb = b % 1024, swz = sb ^ (((sb >> 9) & 1) << 5); R = (st >> 1) * 16 + swz / 64; C = (st & 1) * 32 + (swz % 64) / 2; }
__host__ __device__ __forceinline__ int perm32(int rho) { const int n = rho >> 4, i = rho & 15; return 8 * (i >> 2) + 4 * n + (i & 3); }

struct Unit { int pm, pn; };
struct Gemm { const bf16_t* A; const bf16_t* Bt; int M, N, K; };

struct StaticOrder {
    int nM, nN, nwg, G, c;
    __host__ __device__ void init(int M, int N, int G_, int c_) { nM = M / BM; nN = N / BM; nwg = nM * nN; G = G_; c = c_; }
    __host__ __device__ bool next(int i, Unit& u) const {
        const long L = (long)i * G + c; if (L >= nwg) return false;
        int wgid = (int)L; { const int q = nwg / NXCD, r = nwg % NXCD, xcd = wgid % NXCD, off = wgid / NXCD; wgid = (xcd < r ? xcd * (q + 1) : r * (q + 1) + (xcd - r) * q) + off; }
        const int nig = WGM * nN, gid = wgid / nig, fm = gid * WGM, gsz = (nM - fm) < WGM ? (nM - fm) : WGM;
        u.pm = fm + ((wgid % nig) % gsz); u.pn = (wgid % nig) / gsz; return true;
    }
    __device__ __forceinline__ void a_ready(const Unit&) const {}
    __device__ __forceinline__ void done(const Unit&) const {}
};

__device__ __forceinline__ unsigned cvt_pk_bf16(float lo, float hi) { unsigned r; asm volatile("v_cvt_pk_bf16_f32 %0, %1, %2" : "=v"(r) : "v"(lo), "v"(hi)); return r; }

struct EpiProj {
    static constexpr bool PERM = true, AFTER_DRAIN = false;
    bf16_t* O; int ldc; int ncol_store; const float* bias; float* gatesT; int gcol0; int M;
    __device__ __forceinline__ void operator()(const f32x4 (&acc)[2][2][4][2], const Unit& u, int wr, int wc, int fr, int fq) const {
        const int row0 = u.pm * BM + wr * 64 + fr; const int col0 = u.pn * BM + wc * 32 + 8 * fq;
        f32x4 bv[2][2];
#pragma unroll
        for (int bj = 0; bj < 2; ++bj)
#pragma unroll
            for (int n = 0; n < 2; ++n) bv[bj][n] = *(const f32x4*)(bias + col0 + bj * HALF + 4 * n);
#pragma unroll
        for (int ai = 0; ai < 2; ++ai)
#pragma unroll
            for (int m = 0; m < 4; ++m) { const int row = row0 + ai * HALF + m * 16; bf16_t* rowp = O + (size_t)row * ldc;
#pragma unroll
                for (int bj = 0; bj < 2; ++bj) { const int c = col0 + bj * HALF; const f32x4 v0 = acc[ai][bj][m][0] + bv[bj][0], v1 = acc[ai][bj][m][1] + bv[bj][1];
                    if (c < ncol_store) { u32x4 w; w.x = cvt_pk_bf16(v0[0], v0[1]); w.y = cvt_pk_bf16(v0[2], v0[3]); w.z = cvt_pk_bf16(v1[0], v1[1]); w.w = cvt_pk_bf16(v1[2], v1[3]); *(u32x4*)(rowp + c) = w; }
                    if (c >= gcol0 && c < gcol0 + 16) { float* g = gatesT + (size_t)(c - gcol0) * M + row;
                        g[0] = v0[0]; g[(size_t)M] = v0[1]; g[(size_t)2 * M] = v0[2]; g[(size_t)3 * M] = v0[3]; g[(size_t)4 * M] = v1[0]; g[(size_t)5 * M] = v1[1]; g[(size_t)6 * M] = v1[2]; g[(size_t)7 * M] = v1[3]; } } }
    }
};
struct EpiB16 {
    static constexpr bool PERM = true, AFTER_DRAIN = false;
    bf16_t* O; int ldc;
    __device__ __forceinline__ void operator()(const f32x4 (&acc)[2][2][4][2], const Unit& u, int wr, int wc, int fr, int fq) const {
        const int row0 = u.pm * BM + wr * 64 + fr; const int col0 = u.pn * BM + wc * 32 + 8 * fq;
#pragma unroll
        for (int ai = 0; ai < 2; ++ai)
#pragma unroll
            for (int m = 0; m < 4; ++m) { bf16_t* rowp = O + (size_t)(row0 + ai * HALF + m * 16) * ldc + col0;
#pragma unroll
                for (int bj = 0; bj < 2; ++bj) { const f32x4 v0 = acc[ai][bj][m][0], v1 = acc[ai][bj][m][1];
                    u32x4 w; w.x = cvt_pk_bf16(v0[0], v0[1]); w.y = cvt_pk_bf16(v0[2], v0[3]); w.z = cvt_pk_bf16(v1[0], v1[1]); w.w = cvt_pk_bf16(v1[2], v1[3]); *(u32x4*)(rowp + bj * HALF) = w; } }
    }
};
struct EpiF32 {
    static constexpr bool PERM = false, AFTER_DRAIN = false;
    float* O; int ldc;
    __device__ __forceinline__ void operator()(const f32x4 (&acc)[2][2][4][2], const Unit& u, int wr, int wc, int fr, int fq) const {
        const int row0 = u.pm * BM + wr * 64 + fr; const int col0 = u.pn * BM + wc * 32 + 4 * fq;
#pragma unroll
        for (int ai = 0; ai < 2; ++ai)
#pragma unroll
            for (int m = 0; m < 4; ++m) { float* rowp = O + (size_t)(row0 + ai * HALF + m * 16) * ldc + col0;
#pragma unroll
                for (int bj = 0; bj < 2; ++bj)
#pragma unroll
                    for (int n = 0; n < 2; ++n) *(f32x4*)(rowp + bj * HALF + n * 16) = acc[ai][bj][m][n]; }
    }
};

template <class Epi, class Sched, bool ALIGN_EPI = false, bool SP2 = false>
__device__ __forceinline__ void gemm_phase(PG8_LAS unsigned char* lds, const Gemm g, const Sched& S, const Epi& E) {
    int tid_ = threadIdx.x; asm volatile("" : "+v"(tid_)); const int tid = tid_, wid = __builtin_amdgcn_readfirstlane(tid >> 6), lane = tid & 63, wr = wid >> 2, wc = wid & 3, fr = lane & 15, fq = lane >> 4;
    const int K = g.K, nt = K / BK;
    unsigned voffA[2], voffB[2];
#pragma unroll
    for (int i = 0; i < 2; ++i) { int R, C; stage_rc(tid * 16 + i * 8192, R, C); const int Rb = Epi::PERM ? ((R & ~31) + perm32(R & 31)) : R;
        voffA[i] = (unsigned)(R * K + C) * 2u; voffB[i] = (unsigned)(Rb * K + C) * 2u; }
    const size_t kstep = (size_t)(BK * 2);
    const size_t hstep = (size_t)HALF * K * 2;
    const size_t tstep = 2 * hstep;
    const unsigned ldsw = (unsigned)wid * 1024u;
    const int aoff = lds_byte(wr * 64 + fr, fq * 8), boff = lds_byte(wc * 32 + fr, fq * 8);
#define PG8_SA(b, h) (((b) * 2 + (h)) * HTB)
#define PG8_SB(b, h) ((4 + (b) * 2 + (h)) * HTB)
#define PG8_STAGE(bufoff, gbase, voff) do { _Pragma("unroll") for (int _i = 0; _i < 2; ++_i) \
        __builtin_amdgcn_global_load_lds((const unsigned*)((const char*)(gbase) + (voff)[_i]), (PG8_LAS unsigned*)(lds + (bufoff) + ldsw + _i * 8192), 16, 0, 0); } while (0)
#define PG8_LDA(dst, b, h) do { _Pragma("unroll") for (int m = 0; m < 4; ++m) _Pragma("unroll") for (int k = 0; k < 2; ++k) dst[m][k] = *(const PG8_LAS bf16x8*)(lds + PG8_SA(b, h) + aoff + m * 2048 + k * 1024); } while (0)
#define PG8_LDB(dst, b, h) do { _Pragma("unroll") for (int n = 0; n < 2; ++n) _Pragma("unroll") for (int k = 0; k < 2; ++k) dst[n][k] = *(const PG8_LAS bf16x8*)(lds + PG8_SB(b, h) + boff + n * 2048 + k * 1024); } while (0)
#define PG8_MMA(ai, bj, At, Bt) do { __builtin_amdgcn_s_setprio(1); _Pragma("unroll") for (int m = 0; m < 4; ++m) _Pragma("unroll") for (int n = 0; n < 2; ++n) _Pragma("unroll") for (int k = 0; k < 2; ++k) \
        acc[ai][bj][m][n] = __builtin_amdgcn_mfma_f32_16x16x32_bf16(Bt[n][k], At[m][k], acc[ai][bj][m][n], 0, 0, 0); __builtin_amdgcn_s_setprio(0); } while (0)
#define PG8_WAIT_V(n) asm volatile("s_waitcnt vmcnt(" #n ")" ::: "memory")
#define PG8_WAIT_L(n) asm volatile("s_waitcnt lgkmcnt(" #n ")" ::: "memory")
#define PG8_BAR __builtin_amdgcn_s_barrier()
#define PG8_SCHED __builtin_amdgcn_sched_barrier(0)
    Unit cur, nxt; int ui = 0;
    if (!S.next(0, cur)) return;
    f32x4 acc[2][2][4][2];
#pragma unroll
    for (int a = 0; a < 2; ++a)
#pragma unroll
        for (int b = 0; b < 2; ++b)
#pragma unroll
            for (int m = 0; m < 4; ++m)
#pragma unroll
                for (int n = 0; n < 2; ++n) acc[a][b][m][n] = (f32x4){0.f, 0.f, 0.f, 0.f};
    bf16x8 At[4][2], B0[2][2], B1[2][2];
    const char* cA = (const char*)g.A + (size_t)cur.pm * tstep; const char* cB = (const char*)g.Bt + (size_t)cur.pn * tstep;
    S.a_ready(cur);
    if constexpr (SP2) {
        PG8_STAGE(PG8_SB(0, 0), cB, voffB); PG8_STAGE(PG8_SB(0, 1), cB + hstep, voffB); PG8_STAGE(PG8_SA(0, 0), cA, voffA); PG8_STAGE(PG8_SA(0, 1), cA + hstep, voffA);
        if (wr == 1) PG8_BAR;
        PG8_WAIT_V(2); PG8_BAR;
        PG8_STAGE(PG8_SB(1, 0), cB + kstep, voffB); PG8_STAGE(PG8_SA(1, 0), cA + kstep, voffA); PG8_STAGE(PG8_SB(1, 1), cB + hstep + kstep, voffB);
        PG8_WAIT_V(6); PG8_BAR;
    } else {
        PG8_STAGE(PG8_SB(0, 0), cB, voffB); PG8_STAGE(PG8_SA(0, 0), cA, voffA); PG8_STAGE(PG8_SB(0, 1), cB + hstep, voffB); PG8_STAGE(PG8_SA(0, 1), cA + hstep, voffA);
        if (wr == 1) PG8_BAR;
        PG8_WAIT_V(4); PG8_BAR;
        PG8_STAGE(PG8_SB(1, 0), cB + kstep, voffB); PG8_STAGE(PG8_SA(1, 0), cA + kstep, voffA); PG8_STAGE(PG8_SB(1, 1), cB + hstep + kstep, voffB);
        PG8_WAIT_V(6); PG8_BAR;
    }
    for (;;) {
        const bool has_next = S.next(ui + 1, nxt);
        const char* nA = has_next ? (const char*)g.A + (size_t)nxt.pm * tstep : cA; const char* nB = has_next ? (const char*)g.Bt + (size_t)nxt.pn * tstep : cB;
        for (int t = 0; t < nt; t += 2) {
            const bool last = (t == nt - 2);
            const char* a1 = cA + (size_t)(t + 1) * kstep;
            const char* a2 = last ? nA : cA + (size_t)(t + 2) * kstep; const char* b2 = last ? nB : cB + (size_t)(t + 2) * kstep;
            const char* a3 = a2 + kstep; const char* b3 = b2 + kstep;
            if (last && has_next) S.a_ready(nxt);
            if constexpr (SP2) {
            PG8_LDB(B0, 0, 0); PG8_LDB(B1, 0, 1); PG8_SCHED; PG8_LDA(At, 0, 0); PG8_STAGE(PG8_SA(1, 1), a1 + hstep, voffA);
            PG8_WAIT_V(8); PG8_WAIT_L(0); PG8_BAR; PG8_MMA(0, 0, At, B0); PG8_MMA(0, 1, At, B1); PG8_BAR; PG8_SCHED;
            PG8_LDA(At, 0, 1); PG8_STAGE(PG8_SB(0, 0), b2, voffB); PG8_STAGE(PG8_SB(0, 1), b2 + hstep, voffB); PG8_STAGE(PG8_SA(0, 0), a2, voffA);
            PG8_WAIT_V(8); PG8_WAIT_L(0); PG8_BAR; PG8_MMA(1, 0, At, B0); PG8_MMA(1, 1, At, B1); PG8_BAR; PG8_SCHED;
            PG8_LDB(B0, 1, 0); PG8_LDB(B1, 1, 1); PG8_SCHED; PG8_LDA(At, 1, 0); PG8_STAGE(PG8_SA(0, 1), a2 + hstep, voffA);
            PG8_WAIT_V(8); PG8_WAIT_L(0); PG8_BAR; PG8_MMA(0, 0, At, B0); PG8_MMA(0, 1, At, B1); PG8_BAR; PG8_SCHED;
            PG8_LDA(At, 1, 1); PG8_STAGE(PG8_SB(1, 0), b3, voffB); PG8_STAGE(PG8_SB(1, 1), b3 + hstep, voffB); PG8_STAGE(PG8_SA(1, 0), a3, voffA);
            PG8_WAIT_V(8); PG8_WAIT_L(0); PG8_BAR; PG8_MMA(1, 0, At, B0); PG8_MMA(1, 1, At, B1); PG8_BAR; PG8_SCHED;
            } else {
            PG8_LDB(B0, 0, 0); PG8_SCHED; PG8_LDA(At, 0, 0); PG8_STAGE(PG8_SA(1, 1), a1 + hstep, voffA);
            PG8_WAIT_L(8); PG8_BAR; PG8_WAIT_L(0); PG8_MMA(0, 0, At, B0); PG8_BAR; PG8_SCHED;
            PG8_LDB(B1, 0, 1); PG8_STAGE(PG8_SB(0, 0), b2, voffB);
            PG8_BAR; PG8_WAIT_L(0); PG8_MMA(0, 1, At, B1); PG8_BAR;
            PG8_LDA(At, 0, 1); PG8_STAGE(PG8_SA(0, 0), a2, voffA);
            PG8_BAR; PG8_WAIT_L(0); PG8_MMA(1, 0, At, B0); PG8_BAR; PG8_SCHED;
            PG8_STAGE(PG8_SB(0, 1), b2 + hstep, voffB);
            PG8_WAIT_V(6); PG8_BAR; PG8_MMA(1, 1, At, B1); PG8_BAR;
            PG8_LDB(B0, 1, 0); PG8_SCHED; PG8_LDA(At, 1, 0); PG8_STAGE(PG8_SA(0, 1), a2 + hstep, voffA);
            PG8_WAIT_L(8); PG8_BAR; PG8_WAIT_L(0); PG8_MMA(0, 0, At, B0); PG8_BAR; PG8_SCHED;
            PG8_LDB(B1, 1, 1); PG8_STAGE(PG8_SB(1, 0), b3, voffB);
            PG8_BAR; PG8_WAIT_L(0); PG8_MMA(0, 1, At, B1); PG8_BAR;
            PG8_LDA(At, 1, 1); PG8_STAGE(PG8_SA(1, 0), a3, voffA);
            PG8_BAR; PG8_WAIT_L(0); PG8_MMA(1, 0, At, B0); PG8_BAR; PG8_SCHED;
            PG8_STAGE(PG8_SB(1, 1), b3 + hstep, voffB);
            PG8_WAIT_V(6); PG8_BAR; PG8_MMA(1, 1, At, B1); PG8_BAR;
            }
        }
        if constexpr (ALIGN_EPI) { if (wr == 0) PG8_BAR; }
        if constexpr (!Epi::AFTER_DRAIN) { E(acc, cur, wr, wc, fr, fq); S.done(cur); }
        if (!has_next) break;
#pragma unroll
        for (int a = 0; a < 2; ++a)
#pragma unroll
            for (int b = 0; b < 2; ++b)
#pragma unroll
                for (int m = 0; m < 4; ++m)
#pragma unroll
                    for (int n = 0; n < 2; ++n) acc[a][b][m][n] = (f32x4){0.f, 0.f, 0.f, 0.f};
        cur = nxt; cA = nA; cB = nB; ++ui;
        if constexpr (ALIGN_EPI) { if (wr == 1) PG8_BAR; }
    }
    PG8_WAIT_V(0);
    if constexpr (!ALIGN_EPI) { if (wr == 0) PG8_BAR; }
    PG8_BAR;
    if constexpr (Epi::AFTER_DRAIN) { E.fused(acc, cur, wr, wc, fr, fq, lds, wid, lane); S.done(cur); }
#undef PG8_SA
#undef PG8_SB
#undef PG8_STAGE
#undef PG8_LDA
#undef PG8_LDB
#undef PG8_MMA
#undef PG8_WAIT_V
#undef PG8_WAIT_L
#undef PG8_BAR
#undef PG8_SCHED
}
}
#define XB_TMO      128
#define XB_XCNT(j)  (256  + 64 * (j))
#define XB_XSUB(j)  (1280 + 64 * (j))
#define XB_XGEN(j)  (2304 + 64 * (j))
#define XB_TOP      3328
#define XB_TOPGEN   3392
#define XCD_BAR_WORDS 3456
#define XB_SPIN_CAP (1u << 18)

__device__ __forceinline__ unsigned xb_ld(unsigned* p)              { return __hip_atomic_load(p, __ATOMIC_RELAXED, __HIP_MEMORY_SCOPE_AGENT); }
__device__ __forceinline__ unsigned xb_add(unsigned* p, unsigned v) { return __hip_atomic_fetch_add(p, v, __ATOMIC_RELAXED, __HIP_MEMORY_SCOPE_AGENT); }
__device__ __forceinline__ unsigned xb_xcc_id() { return (unsigned)__builtin_amdgcn_s_getreg((3 << 11) | 20) & 0xFu; }
#define XB_SPIN(cond, bar) do { unsigned _sp = 0; while (cond) { __builtin_amdgcn_s_sleep(1); \
    if ((++_sp & 255u) == 0u) { if (xb_ld(&(bar)[XB_TMO])) break; if (_sp > XB_SPIN_CAP) { atomicAdd(&(bar)[XB_TMO], 1u); break; } } } } while (0)

struct XcdBarrier {
    unsigned* bar; unsigned x;
    volatile LAS unsigned* st;
};

__device__ __forceinline__ XcdBarrier xcd_barrier_post(unsigned* bar, volatile LAS unsigned* st) {
    XcdBarrier b; b.bar = bar; b.x = xb_xcc_id(); b.st = st;
    if (threadIdx.x == 0) (void)xb_add(&bar[XB_XCNT(b.x)], 1u);
    return b;
}
__device__ __forceinline__ void xcd_barrier_complete(unsigned* bar, unsigned x, unsigned& nloc, unsigned& nx) {
    const unsigned G = gridDim.x * gridDim.y * gridDim.z;
    unsigned sum, cnt, mine, sp = 0u;
    for (;;) {
        sum = 0u; cnt = 0u; mine = 0u;
#pragma unroll
        for (unsigned j = 0; j < 16; ++j) { const unsigned c = xb_ld(&bar[XB_XCNT(j)]); sum += c; cnt += (c > 0u) ? 1u : 0u; mine = (j == x) ? c : mine; }
        if (sum == G) break;
        __builtin_amdgcn_s_sleep(1);
        if ((++sp & 255u) == 0u) { if (xb_ld(&bar[XB_TMO])) break; if (sp > XB_SPIN_CAP) { atomicAdd(&bar[XB_TMO], 1u); break; } }
    }
    nloc = mine > 0u ? mine : 1u; nx = cnt > 0u ? cnt : 1u;
}

__device__ __forceinline__ void xcd_barrier(const XcdBarrier& b) {
    asm volatile("s_waitcnt vmcnt(0)" ::: "memory");
    __syncthreads();
    if (threadIdx.x == 0) {
        unsigned* bar = b.bar;
        __builtin_amdgcn_s_waitcnt(0);
        unsigned nloc = b.st[0], nx = b.st[1];
        if (nloc == 0u) { xcd_barrier_complete(bar, b.x, nloc, nx); b.st[0] = nloc; b.st[1] = nx; }
        const unsigned old = xb_add(&bar[XB_XSUB(b.x)], 1u);
        const unsigned gen = old / nloc;
        if (old + 1u == (gen + 1u) * nloc) {
            __builtin_amdgcn_fence(__ATOMIC_RELEASE, "agent");
            asm volatile("s_waitcnt vmcnt(0)" ::: "memory");
            const unsigned og = xb_add(&bar[XB_TOP], 1u);
            const unsigned tg = og / nx;
            if (og + 1u == (tg + 1u) * nx) xb_add(&bar[XB_TOPGEN], 1u);
            else XB_SPIN(xb_ld(&bar[XB_TOPGEN]) == tg, bar);
            __builtin_amdgcn_fence(__ATOMIC_ACQUIRE, "agent");
            xb_add(&bar[XB_XGEN(b.x)], 1u);
            asm volatile("s_waitcnt vmcnt(0)" ::: "memory");
        } else {
            XB_SPIN(xb_ld(&bar[XB_XGEN(b.x)]) == gen, bar);
            __builtin_amdgcn_fence(__ATOMIC_ACQUIRE, "agent");
            asm volatile("s_waitcnt vmcnt(0)" ::: "memory");
        }
    }
    __syncthreads();
}

typedef unsigned short bf16;
typedef unsigned v4u __attribute__((ext_vector_type(4)));
typedef unsigned v2u __attribute__((ext_vector_type(2)));
typedef float f32x4 __attribute__((ext_vector_type(4)));
typedef float f32x2 __attribute__((ext_vector_type(2)));
constexpr int NWAVES = 8, NTHR = 512;
constexpr int BATCH = 8, SEQ = 2048, DM = 1024, MTOK = BATCH * SEQ, DEPTH = 4, NMEM = 256, MMEM = BATCH * NMEM;
constexpr int NIN = 3724, NINP = 3840, PP = 3736;
constexpr int P_AQ = 0, P_AK = 256, P_AV = 512, P_AZ = 768, P_BX = 1024, P_BZ = 1280, P_CR = 1536, P_CK = 1792, P_CV = 2048, P_CW = 2304, P_CA = 2368, P_CZ = 2432,
              P_DQ = 2688, P_DK = 2944, P_DV = 3200, P_DZ = 3456, P_G = 3712;
constexpr float NORM_EPS = 1e-6f, GN_EPS = 64e-5f;
constexpr size_t MiB = 1u << 20;
constexpr size_t WS_CTL = 0, CTL_ZERO_BYTES = 1 * MiB;
constexpr size_t WS_WIN = 1 * MiB, WS_WOUT = 9 * MiB, WS_WQ = 11 * MiB, WS_WO = 13 * MiB, WS_WKV = 15 * MiB;
constexpr size_t WS_KV = 19 * MiB;
constexpr size_t WS_MEMN = 27 * MiB;
constexpr size_t WS_BIASP = 254 * MiB;
constexpr size_t WS_BUFA = 31 * MiB;
constexpr size_t WS_BUFP = 63 * MiB;
constexpr size_t WS_GATES = 180 * MiB;
constexpr size_t WS_CUM = 181 * MiB;
constexpr size_t WS_SBON = 181 * MiB + 512 * 1024;
constexpr size_t WS_RR = 182 * MiB, WS_RK = 190 * MiB, WS_RV = 198 * MiB, WS_RKK = 206 * MiB, WS_RB = 214 * MiB;
constexpr size_t WS_RW = 222 * MiB;
constexpr size_t WS_YRAW = 238 * MiB;
constexpr size_t WS_END = 255 * MiB;
static_assert(WS_MEMN + (size_t)MMEM * DM * 2 <= WS_BUFA && WS_BIASP + NINP * 4 <= WS_END, "ws map");
static_assert(WS_BUFP + (size_t)MTOK * PP * 2 <= WS_GATES, "ws map: proj");
constexpr int CW_BAR = 4096;
constexpr int RING_BYTES = 131072, LDSCTL_OFF = RING_BYTES, MISC_OFF = LDSCTL_OFF + 320, LDS_BYTES = 147456;

__device__ __forceinline__ unsigned f2bf(float f) { unsigned u = __builtin_bit_cast(unsigned, f); return (u + 0x7fffu + ((u >> 16) & 1u)) >> 16; }
__device__ __forceinline__ unsigned pk2(float lo, float hi) { return f2bf(lo) | (f2bf(hi) << 16); }
__device__ __forceinline__ float bflo(unsigned w) { return __uint_as_float(w << 16); }
__device__ __forceinline__ float bfhi(unsigned w) { return __uint_as_float(w & 0xffff0000u); }
__device__ __forceinline__ float bf1(bf16 h) { return __uint_as_float((unsigned)h << 16); }
__device__ __forceinline__ float silu_f(float x) { return x / (1.f + __expf(-x)); }
__device__ __forceinline__ float sigmoid_f(float x) { return 1.f / (1.f + __expf(-x)); }
__device__ __forceinline__ float softplus_f(float x) { return fmaxf(x, 0.f) + log1pf(__expf(-fabsf(x))); }
__device__ __forceinline__ float logsigmoid_f(float x) { return fminf(x, 0.f) - log1pf(__expf(-fabsf(x))); }
__device__ __forceinline__ float wave_sum(float v) {
#pragma unroll
    for (int o = 1; o < 64; o <<= 1) v += __shfl_xor(v, o);
    return v;
}
__device__ __forceinline__ float grp16_sum(float v) { v += __shfl_xor(v, 1); v += __shfl_xor(v, 2); v += __shfl_xor(v, 4); v += __shfl_xor(v, 8); return v; }
__device__ __forceinline__ float half_sum(float v) { v += __shfl_xor(v, 1); v += __shfl_xor(v, 2); v += __shfl_xor(v, 4); v += __shfl_xor(v, 8); v += __shfl_xor(v, 16); return v; }
__device__ __forceinline__ void unpack8(const v4u w, float* f) { f[0] = bflo(w.x); f[1] = bfhi(w.x); f[2] = bflo(w.y); f[3] = bfhi(w.y); f[4] = bflo(w.z); f[5] = bfhi(w.z); f[6] = bflo(w.w); f[7] = bfhi(w.w); }

#define CAS __attribute__((address_space(4)))
struct KIn { const CAS unsigned char* kp; __device__ __forceinline__ const float* operator[](int k) const { return *(const float* const CAS*)(kp + 8 * k); } };
struct Args {
    const float* in[28]; float* out; unsigned char* ws; int ph_lo, ph_hi, use_cg, pad;
};

__device__ __forceinline__ void rows_norm_bf16(const float* src, bf16* dst, int nrows, int gw, int ngw, int lane) {
    for (int m = gw; m < nrows; m += ngw) {
        const f32x4* xr = (const f32x4*)(src + (size_t)m * DM) + lane; f32x4 v[4]; float s = 0.f;
#pragma unroll
        for (int j = 0; j < 4; ++j) { v[j] = xr[64 * j]; s += (v[j].x * v[j].x + v[j].y * v[j].y) + (v[j].z * v[j].z + v[j].w * v[j].w); }
        const float rstd = 1.f / sqrtf(wave_sum(s) * (1.f / DM) + NORM_EPS);
        v2u* o8 = (v2u*)(dst + (size_t)m * DM) + lane;
#pragma unroll
        for (int j = 0; j < 4; ++j) { v2u w; w.x = pk2(v[j].x * rstd, v[j].y * rstd); w.y = pk2(v[j].z * rstd, v[j].w * rstd); o8[64 * j] = w; }
    }
}
__device__ __forceinline__ void rows_residual(const float* y, const float* xsrc, float* xdst, bf16* xb, const float* gain, int gw, int ngw, int lane) {
    f32x4 g[4];
#pragma unroll
    for (int j = 0; j < 4; ++j) g[j] = ((const f32x4*)gain)[lane + 64 * j];
    for (int m = gw; m < MTOK; m += ngw) {
        const f32x4* yr = (const f32x4*)(y + (size_t)m * DM) + lane; const f32x4* xr = (const f32x4*)(xsrc + (size_t)m * DM) + lane;
        f32x4 v[4], x[4]; float s = 0.f;
#pragma unroll
        for (int j = 0; j < 4; ++j) { v[j] = yr[64 * j]; x[j] = xr[64 * j]; s += (v[j].x * v[j].x + v[j].y * v[j].y) + (v[j].z * v[j].z + v[j].w * v[j].w); }
        const float rstd = 1.f / sqrtf(wave_sum(s) * (1.f / DM) + NORM_EPS);
        float s2 = 0.f;
#pragma unroll
        for (int j = 0; j < 4; ++j) { x[j] = x[j] + v[j] * rstd * g[j]; s2 += (x[j].x * x[j].x + x[j].y * x[j].y) + (x[j].z * x[j].z + x[j].w * x[j].w); }
        const float rstd2 = 1.f / sqrtf(wave_sum(s2) * (1.f / DM) + NORM_EPS);
        f32x4* xo = (f32x4*)(xdst + (size_t)m * DM) + lane; v2u* o8 = (v2u*)(xb + (size_t)m * DM) + lane;
#pragma unroll
        for (int j = 0; j < 4; ++j) { xo[64 * j] = x[j]; v2u w; w.x = pk2(x[j].x * rstd2, x[j].y * rstd2); w.y = pk2(x[j].z * rstd2, x[j].w * rstd2); o8[64 * j] = w; }
    }
}

__device__ __forceinline__ int inmap(int d) { return d < 768 ? d : (d < 3456 ? d + 8 : (d < 3712 ? d + 12 : (d < 3720 ? d - 2944 : (d < 3724 ? d - 256 : -1)))); }
template <bool MAP>
__device__ __forceinline__ void transpose_item(const float* W, int K, int N, bf16* WT, const float* gain, LAS float* scr, int item, int nblk, int lane) {
    const int kb = item / nblk, nb = item % nblk, k0 = 64 * kb, n0 = 32 * nb;
    const int nd = n0 + (lane & 31); const int src = MAP ? inmap(nd) : nd;
#pragma unroll 8
    for (int i = 0; i < 32; ++i) { const int kk = 2 * i + (lane >> 5); float v = 0.f; if (src >= 0) v = W[(size_t)(k0 + kk) * N + src]; if (gain) v *= gain[k0 + kk]; scr[kk * 33 + (lane & 31)] = v; }
    asm volatile("s_waitcnt lgkmcnt(0)" ::: "memory");
    const int c = lane & 7;
#pragma unroll
    for (int j = 0; j < 4; ++j) { const int n = (lane >> 3) + 8 * j; const LAS float* s = scr + (8 * c) * 33 + n;
        v4u o; o.x = pk2(s[0 * 33], s[1 * 33]); o.y = pk2(s[2 * 33], s[3 * 33]); o.z = pk2(s[4 * 33], s[5 * 33]); o.w = pk2(s[6 * 33], s[7 * 33]);
        *(v4u*)(WT + (size_t)(n0 + n) * K + k0 + 8 * c) = o; }
    asm volatile("s_waitcnt lgkmcnt(0)" ::: "memory");
}
__device__ __forceinline__ void phase_convert(const KIn ain, unsigned char* ws, int l, LAS unsigned char* lds, int gw, int ngw, int wave, int lane) {
    LAS float* scr = (LAS float*)(lds + wave * 16384);
        const float* w_in = ain[4] + (size_t)l * DM * NIN; const float* w_out = ain[21] + (size_t)l * DM * DM; const float* wq = ain[25] + (size_t)l * DM * DM;
    const float* wkv = ain[26] + (size_t)l * DM * 2 * DM; const float* wo = ain[27] + (size_t)l * DM * DM;
    const float* g_pre = ain[2] + l * DM; const float* g_xpre = ain[23] + l * DM; const float* g_mem = ain[22];
    constexpr int I_IN = 16 * (NINP / 32), I_SQ = 16 * (DM / 32), I_KV = 16 * (2 * DM / 32);
    constexpr int NITEMS = I_IN + 3 * I_SQ + I_KV;
    for (int it = gw; it < NITEMS; it += ngw) {
        int r = it;
        if (r < I_IN) { transpose_item<true>(w_in, DM, NIN, (bf16*)(ws + WS_WIN), g_pre, scr, r, NINP / 32, lane); continue; } r -= I_IN;
        if (r < I_SQ) { transpose_item<false>(w_out, DM, DM, (bf16*)(ws + WS_WOUT), nullptr, scr, r, DM / 32, lane); continue; } r -= I_SQ;
        if (r < I_SQ) { transpose_item<false>(wq, DM, DM, (bf16*)(ws + WS_WQ), g_xpre, scr, r, DM / 32, lane); continue; } r -= I_SQ;
        if (r < I_SQ) { transpose_item<false>(wo, DM, DM, (bf16*)(ws + WS_WO), nullptr, scr, r, DM / 32, lane); continue; } r -= I_SQ;
        transpose_item<false>(wkv, DM, 2 * DM, (bf16*)(ws + WS_WKV), g_mem, scr, r, 2 * DM / 32, lane);
    }
    const float* b_in = ain[5] + (size_t)l * NIN; float* bp = (float*)(ws + WS_BIASP);
    for (int d = gw * 64 + lane; d < NINP; d += ngw * 64) { const int s = inmap(d); bp[d] = s >= 0 ? b_in[s] : 0.f; }
}

__device__ __forceinline__ void prep_cumsum(const float* gatesT, float* cum, int gw, int ngw, int lane) {
    for (int seq = gw; seq < 64; seq += ngw) {
        const int g = seq >> 3, b = seq & 7; const float* src = gatesT + (size_t)(4 + g) * MTOK + (size_t)b * SEQ + lane * 32; float* dst = cum + (size_t)g * MTOK + (size_t)b * SEQ + lane * 32;
        float v[32]; float run = 0.f;
#pragma unroll
        for (int i = 0; i < 8; ++i) { const f32x4 x = ((const f32x4*)src)[i]; v[4 * i] = logsigmoid_f(x.x); v[4 * i + 1] = logsigmoid_f(x.y); v[4 * i + 2] = logsigmoid_f(x.z); v[4 * i + 3] = logsigmoid_f(x.w); }
#pragma unroll
        for (int i = 0; i < 32; ++i) { run += v[i]; v[i] = run; }
        float tot = run;
#pragma unroll
        for (int o = 1; o < 64; o <<= 1) { const float t = __shfl_up(tot, o); if (lane >= o) tot += t; }
        const float excl = tot - run;
#pragma unroll
        for (int i = 0; i < 8; ++i) { f32x4 x; x.x = v[4 * i] + excl; x.y = v[4 * i + 1] + excl; x.z = v[4 * i + 2] + excl; x.w = v[4 * i + 3] + excl; ((f32x4*)dst)[i] = x; }
    }
}
__device__ __forceinline__ void prep_foxnorm(bf16* proj, const float* qkg, int gw, int ngw, int lane) {
    const int e0 = (lane & 15) * 4;
    float g0[4], g1[4];
#pragma unroll
    for (int e = 0; e < 4; ++e) { g0[e] = qkg[e0 + e] * 0.125f; g1[e] = qkg[64 + e0 + e]; }
    for (int m = gw; m < MTOK; m += ngw) {
        bf16* row = proj + (size_t)m * PP;
        v2u* qp = (v2u*)(row + P_DQ + lane * 4); v2u* kp = (v2u*)(row + P_DK + lane * 4);
        const v2u qw = *qp, kw = *kp;
        float q[4] = {bflo(qw.x), bfhi(qw.x), bflo(qw.y), bfhi(qw.y)}, k[4] = {bflo(kw.x), bfhi(kw.x), bflo(kw.y), bfhi(kw.y)};
        const float sq = grp16_sum(q[0] * q[0] + q[1] * q[1] + q[2] * q[2] + q[3] * q[3]), sk = grp16_sum(k[0] * k[0] + k[1] * k[1] + k[2] * k[2] + k[3] * k[3]);
        const float rq = 1.f / sqrtf(sq * (1.f / 64.f) + NORM_EPS), rk = 1.f / sqrtf(sk * (1.f / 64.f) + NORM_EPS);
        v2u o; o.x = pk2(q[0] * rq * g0[0], q[1] * rq * g0[1]); o.y = pk2(q[2] * rq * g0[2], q[3] * rq * g0[3]); *qp = o;
        o.x = pk2(k[0] * rk * g1[0], k[1] * rk * g1[1]); o.y = pk2(k[2] * rk * g1[2], k[3] * rk * g1[3]); *kp = o;
    }
}
__device__ __forceinline__ void prep_rwkv(const KIn ain, unsigned char* ws, int l, const bf16* proj, LAS unsigned char* lds, int bid, int nb, int tid) {
        LAS float* lo = (LAS float*)lds;
    const float* mu = ain[10] + l * 896; const float* w0 = ain[11] + l * 256; const float* w2 = ain[12] + (size_t)l * 64 * 256; const float* a0 = ain[13] + l * 256; const float* a2 = ain[14] + (size_t)l * 64 * 256;
    const float* key_k = ain[15] + l * 256; const float* key_a = ain[16] + l * 256; const float* bonus_u = ain[17] + l * 256;
    bf16* rr = (bf16*)(ws + WS_RR); bf16* rk = (bf16*)(ws + WS_RK); bf16* rv = (bf16*)(ws + WS_RV); bf16* rkk = (bf16*)(ws + WS_RKK); bf16* rb = (bf16*)(ws + WS_RB);
    float* rw = (float*)(ws + WS_RW); float* sbon = (float*)(ws + WS_SBON);
    const int c = tid & 255, tg = tid >> 8, lane = tid & 63;
    const float mur = mu[c], muk = mu[256 + c], muv = mu[512 + c], w0c = w0[c], a0c = a0[c], kkc = key_k[c], kac = key_a[c], buc = bonus_u[c];
    for (int it = bid; it < MTOK / 16; it += nb) {
        const int m0 = it * 16;
        __syncthreads();
#pragma unroll
        for (int i = 0; i < 4; ++i) { const int idx = tid + 512 * i, tok = idx >> 7, j = idx & 127; const int m = m0 + tok; const int t = m & (SEQ - 1);
            const float cur = bf1(proj[(size_t)m * PP + P_CW + j]); const float prev = t > 0 ? bf1(proj[(size_t)(m - 1) * PP + P_CW + j]) : 0.f;
            float v = cur + mu[768 + j] * (prev - cur); if (j < 64) v = tanhf(v); lo[tok * 128 + j] = v; }
        __syncthreads();
        float accw[8], acca[8];
#pragma unroll
        for (int i = 0; i < 8; ++i) { accw[i] = 0.f; acca[i] = 0.f; }
        for (int j = 0; j < 64; ++j) { const float w2v = w2[j * 256 + c], a2v = a2[j * 256 + c];
#pragma unroll
            for (int i = 0; i < 8; ++i) { accw[i] += lo[(tg * 8 + i) * 128 + j] * w2v; acca[i] += lo[(tg * 8 + i) * 128 + 64 + j] * a2v; } }
#pragma unroll
        for (int i = 0; i < 8; ++i) { const int m = m0 + tg * 8 + i; const int t = m & (SEQ - 1); const bf16* row = proj + (size_t)m * PP; const bf16* prow = row - PP;
            const float cr = bf1(row[P_CR + c]), ck = bf1(row[P_CK + c]), cv = bf1(row[P_CV + c]);
            const float pr = t > 0 ? bf1(prow[P_CR + c]) : 0.f, pk = t > 0 ? bf1(prow[P_CK + c]) : 0.f, pv = t > 0 ? bf1(prow[P_CV + c]) : 0.f;
            const float r = cr + mur * (pr - cr), k = ck + muk * (pk - ck), v = cv + muv * (pv - cv);
            const float wl = -softplus_f(-(w0c + accw[i])) - 0.5f; const float decay = __expf(-__expf(wl));
            const float av = sigmoid_f(a0c + acca[i]);
            const float kkv = k * kkc; const float ss = wave_sum(kkv * kkv); const float kkn = kkv / fmaxf(sqrtf(ss), 1e-12f);
            const float k2 = k * (1.f + (av - 1.f) * kac); const float bb = kkn * av;
            const float sb = wave_sum(r * k2 * buc);
            const size_t o = (size_t)m * 256 + c;
            rr[o] = (bf16)f2bf(r); rk[o] = (bf16)f2bf(k2); rv[o] = (bf16)f2bf(v); rkk[o] = (bf16)f2bf(kkn); rb[o] = (bf16)f2bf(bb); rw[o] = decay;
            if (lane == 0) sbon[(size_t)m * 4 + (c >> 6)] = sb; }
    }
}
__device__ __forceinline__ void prep_pool(const KIn ain, unsigned char* ws, int l, const bf16* proj, bf16* ybuf, LAS unsigned char* lds, int bid, int nb, int tid) {
    LAS float* pl = (LAS float*)(lds + 16384);
    const float* pw = ain[8] + (size_t)l * 4 * 64 * 64; const float* ps = ain[9] + l * 256;
    const int c = tid & 255, tg = tid >> 8, g = c >> 6, d = c & 63; const int win = 2 << g; const float psc = ps[c];
    for (int it = bid; it < MTOK / 16; it += nb) {
        const int m0 = it * 16 + tg * 8; const int t0 = m0 & (SEQ - 1);
        __syncthreads();
        float vals[23];
#pragma unroll
        for (int i = 0; i < 23; ++i) { const int t = t0 - 15 + i; vals[i] = t >= 0 ? bf1(proj[(size_t)(m0 - 15 + i) * PP + P_BX + c]) : 0.f; }
#pragma unroll
        for (int i = 0; i < 8; ++i) { float s = 0.f;
#pragma unroll
            for (int j = 0; j < 16; ++j) if (j < win) s += vals[15 + i - j];
            const int cnt = min(t0 + i + 1, win); pl[(tg * 8 + i) * 256 + c] = s / (float)cnt - vals[15 + i]; }
        __syncthreads();
        float acc[8];
#pragma unroll
        for (int i = 0; i < 8; ++i) acc[i] = 0.f;
        for (int cc = 0; cc < 64; ++cc) { const float wv = pw[(g * 64 + cc) * 64 + d];
#pragma unroll
            for (int i = 0; i < 8; ++i) acc[i] += pl[(tg * 8 + i) * 256 + g * 64 + cc] * wv; }
#pragma unroll
        for (int i = 0; i < 8; ++i) { const int m = m0 + i; const float z = bf1(proj[(size_t)m * PP + P_BZ + c]); ybuf[(size_t)m * DM + 256 + c] = (bf16)f2bf(acc[i] * psc * silu_f(z)); }
    }
}

__device__ __forceinline__ void mix_mlstm_item(const KIn ain, unsigned char* ws, int l, const bf16* proj, bf16* ybuf, LAS unsigned char* lds, int bh, int qb, int tid) {
        const int b = bh >> 2, h = bh & 3; const int t = qb * 512 + tid; const size_t m = (size_t)b * SEQ + t;
    const float* cw = ain[6] + (size_t)l * 4 * 512;
    const float* gatesT = (const float*)(ws + WS_GATES); const float* cumA = (const float*)(ws + WS_CUM) + (size_t)h * MTOK;
    LAS float* Ks = (LAS float*)lds; LAS float* Vs = (LAS float*)(lds + 16384); LAS float* gs = (LAS float*)(lds + 32768);
    float q[64], acc[64];
#pragma unroll
    for (int d8 = 0; d8 < 8; ++d8) { float s[8];
#pragma unroll
        for (int e = 0; e < 8; ++e) s[e] = 0.f;
#pragma unroll
        for (int j = 0; j < 4; ++j) { const int tt = t - 3 + j; if (tt >= 0) { const v4u w = *(const v4u*)(proj + (m - 3 + j) * PP + P_AQ + h * 64 + d8 * 8); float f[8]; unpack8(w, f);
#pragma unroll
                for (int e = 0; e < 8; ++e) s[e] += f[e] * cw[j * 512 + h * 64 + d8 * 8 + e]; } }
#pragma unroll
        for (int e = 0; e < 8; ++e) q[d8 * 8 + e] = silu_f(s[e]); }
#pragma unroll
    for (int d = 0; d < 64; ++d) acc[d] = 0.f;
    float den = 0.f; const float bt = cumA[m];
    const int skey = tid >> 3, sd0 = (tid & 7) * 8;
    const int nt = (qb * 512 + 512) / 64;
    for (int kt = 0; kt < nt; ++kt) {
        __syncthreads();
        { const int s = kt * 64 + skey; const size_t ms = (size_t)b * SEQ + s; float sk[8];
#pragma unroll
            for (int e = 0; e < 8; ++e) sk[e] = 0.f;
#pragma unroll
            for (int j = 0; j < 4; ++j) { const int tt = s - 3 + j; if (tt >= 0) { const v4u w = *(const v4u*)(proj + (ms - 3 + j) * PP + P_AK + h * 64 + sd0); float f[8]; unpack8(w, f);
#pragma unroll
                    for (int e = 0; e < 8; ++e) sk[e] += f[e] * cw[j * 512 + 256 + h * 64 + sd0 + e]; } }
#pragma unroll
            for (int e = 0; e < 8; ++e) Ks[skey * 64 + sd0 + e] = silu_f(sk[e]) * 0.125f;
            const v4u w = *(const v4u*)(proj + ms * PP + P_AV + h * 64 + sd0); float f[8]; unpack8(w, f);
#pragma unroll
            for (int e = 0; e < 8; ++e) Vs[skey * 64 + sd0 + e] = f[e];
            if (tid < 64) { const size_t mk = (size_t)b * SEQ + kt * 64 + tid; gs[tid] = gatesT[(size_t)h * MTOK + mk] - cumA[mk]; } }
        __syncthreads();
        const int kmax = min(64, t - kt * 64 + 1);
        for (int key = 0; key < kmax; ++key) {
            float dot = 0.f;
#pragma unroll
            for (int d4 = 0; d4 < 16; ++d4) { const f32x4 kv = *(const LAS f32x4*)(Ks + key * 64 + d4 * 4); dot += q[d4 * 4] * kv.x + q[d4 * 4 + 1] * kv.y + q[d4 * 4 + 2] * kv.z + q[d4 * 4 + 3] * kv.w; }
            const float w = dot * __expf(bt + gs[key]); den += w;
#pragma unroll
            for (int d4 = 0; d4 < 16; ++d4) { const f32x4 vv = *(const LAS f32x4*)(Vs + key * 64 + d4 * 4); acc[d4 * 4] += w * vv.x; acc[d4 * 4 + 1] += w * vv.y; acc[d4 * 4 + 2] += w * vv.z; acc[d4 * 4 + 3] += w * vv.w; }
        }
    }
    const float inv = 1.f / fmaxf(fabsf(den), 1.f); float ss = 0.f;
#pragma unroll
    for (int d = 0; d < 64; ++d) { acc[d] *= inv; ss += acc[d] * acc[d]; }
    const float rs = 1.f / sqrtf(ss * (1.f / 64.f) + NORM_EPS);
    const float* ng = ain[7] + l * 256 + h * 64;
#pragma unroll
    for (int d8 = 0; d8 < 8; ++d8) { const v4u zw = *(const v4u*)(proj + m * PP + P_AZ + h * 64 + d8 * 8); float z[8]; unpack8(zw, z); v4u o;
        float y[8];
#pragma unroll
        for (int e = 0; e < 8; ++e) y[e] = acc[d8 * 8 + e] * rs * ng[d8 * 8 + e] * silu_f(z[e]);
        o.x = pk2(y[0], y[1]); o.y = pk2(y[2], y[3]); o.z = pk2(y[4], y[5]); o.w = pk2(y[6], y[7]);
        *(v4u*)(ybuf + m * DM + 0 + h * 64 + d8 * 8) = o; }
}
__device__ __forceinline__ void mix_fox_item(const KIn ain, unsigned char* ws, int l, const bf16* proj, bf16* ybuf, LAS unsigned char* lds, int bh, int qb, int tid) {
        const int b = bh >> 2, h = bh & 3; const int t = qb * 512 + tid; const size_t m = (size_t)b * SEQ + t;
    const float* cumD = (const float*)(ws + WS_CUM) + (size_t)(4 + h) * MTOK;
    LAS float* Ks = (LAS float*)lds; LAS float* Vs = (LAS float*)(lds + 16384); LAS float* gs = (LAS float*)(lds + 32768);
    float q[64], acc[64];
#pragma unroll
    for (int d8 = 0; d8 < 8; ++d8) { const v4u w = *(const v4u*)(proj + m * PP + P_DQ + h * 64 + d8 * 8); unpack8(w, q + d8 * 8); }
#pragma unroll
    for (int d = 0; d < 64; ++d) acc[d] = 0.f;
    float mx = -1e30f, lsum = 0.f; const float ft = cumD[m];
    const int skey = tid >> 3, sd0 = (tid & 7) * 8;
    const int nt = (qb * 512 + 512) / 64;
    for (int kt = 0; kt < nt; ++kt) {
        __syncthreads();
        { const int s = kt * 64 + skey; const size_t ms = (size_t)b * SEQ + s;
            const v4u kw = *(const v4u*)(proj + ms * PP + P_DK + h * 64 + sd0); float f[8]; unpack8(kw, f);
#pragma unroll
            for (int e = 0; e < 8; ++e) Ks[skey * 64 + sd0 + e] = f[e];
            const v4u w = *(const v4u*)(proj + ms * PP + P_DV + h * 64 + sd0); unpack8(w, f);
#pragma unroll
            for (int e = 0; e < 8; ++e) Vs[skey * 64 + sd0 + e] = f[e];
            if (tid < 64) gs[tid] = cumD[(size_t)b * SEQ + kt * 64 + tid]; }
        __syncthreads();
        const int kmax = min(64, t - kt * 64 + 1);
        for (int key = 0; key < kmax; ++key) {
            float dot = 0.f;
#pragma unroll
            for (int d4 = 0; d4 < 16; ++d4) { const f32x4 kv = *(const LAS f32x4*)(Ks + key * 64 + d4 * 4); dot += q[d4 * 4] * kv.x + q[d4 * 4 + 1] * kv.y + q[d4 * 4 + 2] * kv.z + q[d4 * 4 + 3] * kv.w; }
            const float sc = dot + ft - gs[key];
            if (sc > mx) { const float f = __expf(mx - sc); lsum *= f;
#pragma unroll
                for (int d = 0; d < 64; ++d) acc[d] *= f;
                mx = sc; }
            const float p = __expf(sc - mx); lsum += p;
#pragma unroll
            for (int d4 = 0; d4 < 16; ++d4) { const f32x4 vv = *(const LAS f32x4*)(Vs + key * 64 + d4 * 4); acc[d4 * 4] += p * vv.x; acc[d4 * 4 + 1] += p * vv.y; acc[d4 * 4 + 2] += p * vv.z; acc[d4 * 4 + 3] += p * vv.w; }
        }
    }
    const float inv = 1.f / lsum;
#pragma unroll
    for (int d8 = 0; d8 < 8; ++d8) { const v4u zw = *(const v4u*)(proj + m * PP + P_DZ + h * 64 + d8 * 8); float z[8]; unpack8(zw, z); v4u o;
        float y[8];
#pragma unroll
        for (int e = 0; e < 8; ++e) y[e] = acc[d8 * 8 + e] * inv * silu_f(z[e]);
        o.x = pk2(y[0], y[1]); o.y = pk2(y[2], y[3]); o.z = pk2(y[4], y[5]); o.w = pk2(y[6], y[7]);
        *(v4u*)(ybuf + m * DM + 768 + h * 64 + d8 * 8) = o; }
}
__device__ __forceinline__ void mix_rwkv_item(const KIn ain, unsigned char* ws, int bh, int rg, int tid) {
        const bf16* rr = (const bf16*)(ws + WS_RR); const bf16* rk = (const bf16*)(ws + WS_RK); const bf16* rv = (const bf16*)(ws + WS_RV); const bf16* rkk = (const bf16*)(ws + WS_RKK); const bf16* rb = (const bf16*)(ws + WS_RB);
    const float* rw = (const float*)(ws + WS_RW); float* yraw = (float*)(ws + WS_YRAW);
    const int b = bh >> 2, h = bh & 3; const int wave = tid >> 6, lane = tid & 63, j = lane & 31; const int row = rg * 16 + wave * 2 + (lane >> 5);
    const size_t base0 = ((size_t)b * SEQ) * 256 + h * 64;
    float S0 = 0.f, S1 = 0.f;
#pragma unroll 4
    for (int t = 0; t < SEQ; ++t) {
        const size_t base = base0 + (size_t)t * 256;
        const f32x2 w = *(const f32x2*)(rw + base + 2 * j);
        const unsigned kkw = *(const unsigned*)(rkk + base + 2 * j), bw = *(const unsigned*)(rb + base + 2 * j), kw = *(const unsigned*)(rk + base + 2 * j), rw_ = *(const unsigned*)(rr + base + 2 * j);
        const float vv = bf1(rv[base + row]);
        const float sa = -half_sum(S0 * bflo(kkw) + S1 * bfhi(kkw));
        S0 = S0 * w.x + sa * bflo(bw) + vv * bflo(kw); S1 = S1 * w.y + sa * bfhi(bw) + vv * bfhi(kw);
        const float y = half_sum(S0 * bflo(rw_) + S1 * bfhi(rw_));
        if (j == 0) yraw[base + row] = y;
    }
}
__device__ __forceinline__ void phase_mix(const KIn ain, unsigned char* ws, int l, const bf16* proj, bf16* ybuf, LAS unsigned char* lds, int bid, int nb, int tid) {
    for (int it = bid; it < 384; it += nb) {
        if (it < 128) { mix_rwkv_item(ain, ws, it >> 2, it & 3, tid); continue; }
        const int j = it - 128; const int qb = 3 - (j >> 6), rest = j & 63, bh = rest >> 1;
        if (rest & 1) mix_fox_item(ain, ws, l, proj, ybuf, lds, bh, qb, tid); else mix_mlstm_item(ain, ws, l, proj, ybuf, lds, bh, qb, tid);
    }
}
__device__ __forceinline__ void phase_rwkv_post(const KIn ain, unsigned char* ws, int l, const bf16* proj, bf16* ybuf, int gw, int ngw, int lane) {
        const float* yraw = (const float*)(ws + WS_YRAW); const float* sbon = (const float*)(ws + WS_SBON); const bf16* rv = (const bf16*)(ws + WS_RV);
    const f32x4 gg = ((const f32x4*)(ain[18] + l * 256))[lane], gb = ((const f32x4*)(ain[19] + l * 256))[lane];
    for (int m = gw; m < MTOK; m += ngw) {
        const f32x4 y = ((const f32x4*)(yraw + (size_t)m * 256))[lane];
        const float mean = grp16_sum((y.x + y.y) + (y.z + y.w)) * (1.f / 64.f);
        const f32x4 dlt = y - mean; const float var = grp16_sum((dlt.x * dlt.x + dlt.y * dlt.y) + (dlt.z * dlt.z + dlt.w * dlt.w)) * (1.f / 64.f);
        const float rs = 1.f / sqrtf(var + GN_EPS); const float sb = sbon[(size_t)m * 4 + (lane >> 4)];
        const v2u vw = *(const v2u*)(rv + (size_t)m * 256 + lane * 4); const v2u zw = *(const v2u*)(proj + (size_t)m * PP + P_CZ + lane * 4);
        const float o0 = (dlt.x * rs * gg.x + gb.x + sb * bflo(vw.x)) * silu_f(bflo(zw.x)), o1 = (dlt.y * rs * gg.y + gb.y + sb * bfhi(vw.x)) * silu_f(bfhi(zw.x));
        const float o2 = (dlt.z * rs * gg.z + gb.z + sb * bflo(vw.y)) * silu_f(bflo(zw.y)), o3 = (dlt.w * rs * gg.w + gb.w + sb * bfhi(vw.y)) * silu_f(bfhi(zw.y));
        v2u o; o.x = pk2(o0, o1); o.y = pk2(o2, o3); *(v2u*)(ybuf + (size_t)m * DM + 512 + lane * 4) = o;
    }
}
__device__ __forceinline__ void phase_xattn(const KIn ain, unsigned char* ws, const bf16* qbuf, bf16* obuf, LAS unsigned char* lds, int bid, int nb, int tid) {
    const bf16* kv = (const bf16*)(ws + WS_KV);
    LAS bf16* Ks = (LAS bf16*)lds; LAS bf16* Vs = (LAS bf16*)(lds + 32768);
    const int qi = tid >> 2, part = tid & 3;
    for (int it = bid; it < 512; it += nb) {
        const int qb = it & 15, h = (it >> 4) & 3, b = it >> 6; const size_t m = (size_t)b * SEQ + qb * 128 + qi;
        float q[64], acc[64];
#pragma unroll
        for (int d8 = 0; d8 < 8; ++d8) { const v4u w = *(const v4u*)(qbuf + m * DM + h * 256 + part * 64 + d8 * 8); unpack8(w, q + d8 * 8); }
#pragma unroll
        for (int d = 0; d < 64; ++d) acc[d] = 0.f;
        float mx = -1e30f, lsum = 0.f;
        for (int kt = 0; kt < 4; ++kt) {
            __syncthreads();
#pragma unroll
            for (int i = 0; i < 4; ++i) { const int idx = tid + 512 * i, key = idx >> 5, c8 = (idx & 31) * 8; const size_t mr = (size_t)b * NMEM + kt * 64 + key;
                *(LAS v4u*)(Ks + key * 256 + c8) = *(const v4u*)(kv + mr * 2048 + h * 256 + c8); *(LAS v4u*)(Vs + key * 256 + c8) = *(const v4u*)(kv + mr * 2048 + 1024 + h * 256 + c8); }
            __syncthreads();
            for (int key = 0; key < 64; ++key) {
                float dot = 0.f;
#pragma unroll
                for (int d8 = 0; d8 < 8; ++d8) { const v4u w = *(const LAS v4u*)(Ks + key * 256 + part * 64 + d8 * 8); float f[8]; unpack8(w, f);
#pragma unroll
                    for (int e = 0; e < 8; ++e) dot += q[d8 * 8 + e] * f[e]; }
                dot += __shfl_xor(dot, 1); dot += __shfl_xor(dot, 2);
                const float sc = dot * 0.0625f;
                if (sc > mx) { const float f = __expf(mx - sc); lsum *= f;
#pragma unroll
                    for (int d = 0; d < 64; ++d) acc[d] *= f;
                    mx = sc; }
                const float p = __expf(sc - mx); lsum += p;
#pragma unroll
                for (int d8 = 0; d8 < 8; ++d8) { const v4u w = *(const LAS v4u*)(Vs + key * 256 + part * 64 + d8 * 8); float f[8]; unpack8(w, f);
#pragma unroll
                    for (int e = 0; e < 8; ++e) acc[d8 * 8 + e] += p * f[e]; }
            }
        }
        const float inv = 1.f / lsum;
#pragma unroll
        for (int d8 = 0; d8 < 8; ++d8) { v4u o; o.x = pk2(acc[d8 * 8] * inv, acc[d8 * 8 + 1] * inv); o.y = pk2(acc[d8 * 8 + 2] * inv, acc[d8 * 8 + 3] * inv); o.z = pk2(acc[d8 * 8 + 4] * inv, acc[d8 * 8 + 5] * inv); o.w = pk2(acc[d8 * 8 + 6] * inv, acc[d8 * 8 + 7] * inv);
            *(v4u*)(obuf + m * DM + h * 256 + part * 64 + d8 * 8) = o; }
    }
}

constexpr int PH_PER_LAYER = 12, N_PHASES = 1 + DEPTH * PH_PER_LAYER;
__global__ void __launch_bounds__(NTHR, 2) mk_fwd(Args args) {
    extern __shared__ __attribute__((aligned(16))) unsigned char lds_raw[];
    LAS unsigned char* lds = (LAS unsigned char*)lds_raw;
    unsigned char* ws0 = args.ws;
    volatile LAS unsigned* MISC = (volatile LAS unsigned*)(lds + MISC_OFF);
    for (int u = threadIdx.x; u < (LDS_BYTES - LDSCTL_OFF) / 4; u += NTHR) ((LAS unsigned*)(lds + LDSCTL_OFF))[u] = 0u;
    __syncthreads();
    XcdBarrier bar; bar.bar = (unsigned*)(ws0 + WS_CTL) + CW_BAR; bar.x = 0; bar.st = nullptr;
    const bool multi = (args.ph_hi - args.ph_lo) > 1;
    if (multi && !args.use_cg) bar = xcd_barrier_post((unsigned*)(ws0 + WS_CTL) + CW_BAR, MISC + 8);
    float* xout = args.out;
    for (int ph = args.ph_lo; ph < args.ph_hi; ++ph) {
        int tid = threadIdx.x; asm volatile("" : "+v"(tid));
        int bid = blockIdx.x, G = gridDim.x; unsigned char* ws = ws0; asm volatile("" : "+s"(bid), "+s"(G), "+s"(ws));
        KIn ain; ain.kp = (const CAS unsigned char*)__builtin_amdgcn_kernarg_segment_ptr(); asm volatile("" : "+s"(ain.kp));
        const int lane = tid & 63, wave = __builtin_amdgcn_readfirstlane(tid >> 6); const int gw = bid * NWAVES + wave, ngw = G * NWAVES;
        bf16* bufA = (bf16*)(ws + WS_BUFA); bf16* proj = (bf16*)(ws + WS_BUFP); float* ytmp = (float*)(ws + WS_BUFP); bf16* qbuf = (bf16*)(ws + WS_BUFP + 64 * MiB);
        if (ph == 0) {
            rows_norm_bf16(ain[0], bufA, MTOK, gw, ngw, lane);
            rows_norm_bf16(ain[1], (bf16*)(ws + WS_MEMN), MMEM, gw, ngw, lane);
        } else {
            const int l = (ph - 1) / PH_PER_LAYER, s = (ph - 1) % PH_PER_LAYER;
#ifndef PHMASK
#define PHMASK 0xFFF
#endif
            switch (s) {
            case 0: if (!((PHMASK >> 0) & 1)) break; phase_convert(ain, ws, l, lds, gw, ngw, wave, lane); break;
            case 1: if (!((PHMASK >> 1) & 1)) break; { pg8::Gemm g{(const bf16*)(ws + WS_MEMN), (const bf16*)(ws + WS_WKV), MMEM, 2 * DM, DM}; pg8::StaticOrder S; S.init(MMEM, 2 * DM, G, bid);
                      pg8::EpiB16 E{(bf16*)(ws + WS_KV), 2 * DM}; pg8::gemm_phase<pg8::EpiB16, pg8::StaticOrder, true, true>(lds, g, S, E); } break;
            case 2: if (!((PHMASK >> 2) & 1)) break; { pg8::Gemm g{bufA, (const bf16*)(ws + WS_WIN), MTOK, NINP, DM}; pg8::StaticOrder S; S.init(MTOK, NINP, G, bid);
                      pg8::EpiProj E{proj, PP, PP, (const float*)(ws + WS_BIASP), (float*)(ws + WS_GATES), P_G, MTOK}; pg8::gemm_phase<pg8::EpiProj, pg8::StaticOrder, true, true>(lds, g, S, E); } break;
            case 3: if (!((PHMASK >> 3) & 1)) break; prep_cumsum((const float*)(ws + WS_GATES), (float*)(ws + WS_CUM), gw, ngw, lane);
                    prep_foxnorm(proj, ain[20] + l * 128, gw, ngw, lane);
                    prep_rwkv(ain, ws, l, proj, lds, bid, G, tid);
                    prep_pool(ain, ws, l, proj, bufA, lds, bid, G, tid); break;
            case 4: if (!((PHMASK >> 4) & 1)) break; phase_mix(ain, ws, l, proj, bufA, lds, bid, G, tid); break;
            case 5: if (!((PHMASK >> 5) & 1)) break; phase_rwkv_post(ain, ws, l, proj, bufA, gw, ngw, lane); break;
            case 6: if (!((PHMASK >> 6) & 1)) break; { pg8::Gemm g{bufA, (const bf16*)(ws + WS_WOUT), MTOK, DM, DM}; pg8::StaticOrder S; S.init(MTOK, DM, G, bid);
                      pg8::EpiF32 E{ytmp, DM}; pg8::gemm_phase<pg8::EpiF32, pg8::StaticOrder, true, true>(lds, g, S, E); } break;
            case 7: if (!((PHMASK >> 7) & 1)) break; rows_residual(ytmp, l == 0 ? ain[0] : xout, xout, bufA, ain[3] + l * DM, gw, ngw, lane); break;
            case 8: if (!((PHMASK >> 8) & 1)) break; { pg8::Gemm g{bufA, (const bf16*)(ws + WS_WQ), MTOK, DM, DM}; pg8::StaticOrder S; S.init(MTOK, DM, G, bid);
                      pg8::EpiB16 E{qbuf, DM}; pg8::gemm_phase<pg8::EpiB16, pg8::StaticOrder, true, true>(lds, g, S, E); } break;
            case 9: if (!((PHMASK >> 9) & 1)) break; phase_xattn(ain, ws, qbuf, bufA, lds, bid, G, tid); break;
            case 10: if (!((PHMASK >> 10) & 1)) break; { pg8::Gemm g{bufA, (const bf16*)(ws + WS_WO), MTOK, DM, DM}; pg8::StaticOrder S; S.init(MTOK, DM, G, bid);
                       pg8::EpiF32 E{ytmp, DM}; pg8::gemm_phase<pg8::EpiF32, pg8::StaticOrder, true, true>(lds, g, S, E); } break;
            case 11: if (!((PHMASK >> 11) & 1)) break; rows_residual(ytmp, xout, xout, bufA, ain[24] + l * DM, gw, ngw, lane); break;
            }
        }
        if (ph + 1 < args.ph_hi) { if (args.use_cg) { cg::this_grid().sync(); } else { xcd_barrier(bar); } }
    }
}

#ifndef MK_SPLIT
#define MK_SPLIT 0
#endif
extern "C" void kernel_launch(void* const* d_in, const int* in_sizes, int n_in, void* d_out, int out_size, void* d_ws, size_t ws_size, hipStream_t stream) {
    static int grid = 0;
    if (grid == 0) {
        if (n_in != 28 || out_size != MTOK * DM || ws_size < WS_END) { fprintf(stderr, "kernel_launch: unexpected shapes (n_in %d out %d ws %zu)\n", n_in, out_size, ws_size); grid = -1; return; }
        int dev = 0, cus = 0, per_cu = 0;
        hipGetDevice(&dev); hipDeviceGetAttribute(&cus, hipDeviceAttributeMultiprocessorCount, dev);
        hipFuncSetAttribute((const void*)mk_fwd, hipFuncAttributeMaxDynamicSharedMemorySize, LDS_BYTES);
        hipOccupancyMaxActiveBlocksPerMultiprocessor(&per_cu, (const void*)mk_fwd, NTHR, LDS_BYTES);
        (void)hipGetLastError();
        if (per_cu < 1) { fprintf(stderr, "kernel_launch: occupancy query says %d blocks/CU\n", per_cu); }
        grid = cus;
    }
    if (grid < 0) return;
    hipMemsetAsync((char*)d_ws + WS_CTL, 0, CTL_ZERO_BYTES, stream);
    Args a{};
    for (int i = 0; i < 28; ++i) a.in[i] = (const float*)d_in[i];
    a.out = (float*)d_out; a.ws = (unsigned char*)d_ws; a.use_cg = 0; a.pad = 0;
#if MK_SPLIT
    for (int ph = 0; ph < N_PHASES; ++ph) { a.ph_lo = ph; a.ph_hi = ph + 1; hipLaunchKernelGGL(mk_fwd, dim3(grid), dim3(NTHR), LDS_BYTES, stream, a); }
#else
    a.ph_lo = 0; a.ph_hi = N_PHASES;
    void* kargs[] = {&a};
    hipError_t e = hipLaunchCooperativeKernel((const void*)mk_fwd, dim3(grid), dim3(NTHR), kargs, LDS_BYTES, stream);
    if (e != hipSuccess) fprintf(stderr, "cooperative launch failed: %s (grid %d)\n", hipGetErrorString(e), grid);
#endif
}
```

```cpp
#include <hip/hip_runtime.h>
#include <hip/hip_cooperative_groups.h>
#include <cstdio>
#include <cstdint>
namespace cg = cooperative_groups;
#define GAS __attribute__((address_space(1)))
#define LAS __attribute__((address_space(3)))
namespace pg8 {
#define PG8_LAS __attribute__((address_space(3)))
typedef unsigned short bf16_t;
typedef short bf16x8 __attribute__((ext_vector_type(8)));
typedef float f32x4 __attribute__((ext_vector_type(4)));
typedef unsigned u32x4 __attribute__((ext_vector_type(4)));
constexpr int BM = 256, BK = 64, HALF = 128, HTB = HALF * BK * 2  , STAGE_BYTES = 8 * HTB, NXCD = 8, WGM = 8;

__host__ __device__ __forceinline__ int lds_byte(int r, int c) { const int st = (r >> 4) * 2 + (c >> 5), rr = r & 15, cc = c & 31, ob = rr * 64 + cc * 2; return st * 1024 + (ob ^ (((ob >> 9) & 1) << 5)); }
__host__ __device__ __forceinline__ void stage_rc(int b, int& R, int& C) { const int st = b / 1024, sb = b % 1024, swz = sb ^ (((sb >> 9) & 1) << 5); R = (st >> 1) * 16 + swz / 64; C = (st & 1) * 32 + (swz % 64) / 2; }
__host__ __device__ __forceinline__ int perm32(int rho) { const int n = rho >> 4, i = rho & 15; return 8 * (i >> 2) + 4 * n + (i & 3); }

struct Unit { int pm, pn; };
struct Gemm { const bf16_t* A; const bf16_t* Bt; int M, N, K; };

struct StaticOrder {
    int nM, nN, nwg, G, c;
    __host__ __device__ void init(int M, int N, int G_, int c_) { nM = M / BM; nN = N / BM; nwg = nM * nN; G = G_; c = c_; }
    __host__ __device__ bool next(int i, Unit& u) const {
        const long L = (long)i * G + c; if (L >= nwg) return false;
        int wgid = (int)L; { const int q = nwg / NXCD, r = nwg % NXCD, xcd = wgid % NXCD, off = wgid / NXCD; wgid = (xcd < r ? xcd * (q + 1) : r * (q + 1) + (xcd - r) * q) + off; }
        const int nig = WGM * nN, gid = wgid / nig, fm = gid * WGM, gsz = (nM - fm) < WGM ? (nM - fm) : WGM;
        u.pm = fm + ((wgid % nig) % gsz); u.pn = (wgid % nig) / gsz; return true;
    }
    __device__ __forceinline__ void a_ready(const Unit&) const {}
    __device__ __forceinline__ void done(const Unit&) const {}
};

__device__ __forceinline__ unsigned cvt_pk_bf16(float lo, float hi) { unsigned r; asm volatile("v_cvt_pk_bf16_f32 %0, %1, %2" : "=v"(r) : "v"(lo), "v"(hi)); return r; }

struct EpiProj {
    static constexpr bool PERM = true, AFTER_DRAIN = false;
    bf16_t* O; int ldc; int ncol_store; const float* bias; float* gatesT; int gcol0; int M;
    __device__ __forceinline__ void operator()(const f32x4 (&acc)[2][2][4][2], const Unit& u, int wr, int wc, int fr, int fq) const {
        const int row0 = u.pm * BM + wr * 64 + fr; const int col0 = u.pn * BM + wc * 32 + 8 * fq;
        f32x4 bv[2][2];
#pragma unroll
        for (int bj = 0; bj < 2; ++bj)
#pragma unroll
            for (int n = 0; n < 2; ++n) bv[bj][n] = *(const f32x4*)(bias + col0 + bj * HALF + 4 * n);
#pragma unroll
        for (int ai = 0; ai < 2; ++ai)
#pragma unroll
            for (int m = 0; m < 4; ++m) { const int row = row0 + ai * HALF + m * 16; bf16_t* rowp = O + (size_t)row * ldc;
#pragma unroll
                for (int bj = 0; bj < 2; ++bj) { const int c = col0 + bj * HALF; const f32x4 v0 = acc[ai][bj][m][0] + bv[bj][0], v1 = acc[ai][bj][m][1] + bv[bj][1];
                    if (c < ncol_store) { u32x4 w; w.x = cvt_pk_bf16(v0[0], v0[1]); w.y = cvt_pk_bf16(v0[2], v0[3]); w.z = cvt_pk_bf16(v1[0], v1[1]); w.w = cvt_pk_bf16(v1[2], v1[3]); *(u32x4*)(rowp + c) = w; }
                    if (c >= gcol0 && c < gcol0 + 16) { float* g = gatesT + (size_t)(c - gcol0) * M + row;
                        g[0] = v0[0]; g[(size_t)M] = v0[1]; g[(size_t)2 * M] = v0[2]; g[(size_t)3 * M] = v0[3]; g[(size_t)4 * M] = v1[0]; g[(size_t)5 * M] = v1[1]; g[(size_t)6 * M] = v1[2]; g[(size_t)7 * M] = v1[3]; } } }
    }
};
struct EpiB16 {
    static constexpr bool PERM = true, AFTER_DRAIN = false;
    bf16_t* O; int ldc;
    __device__ __forceinline__ void operator()(const f32x4 (&acc)[2][2][4][2], const Unit& u, int wr, int wc, int fr, int fq) const {
        const int row0 = u.pm * BM + wr * 64 + fr; const int col0 = u.pn * BM + wc * 32 + 8 * fq;
#pragma unroll
        for (int ai = 0; ai < 2; ++ai)
#pragma unroll
            for (int m = 0; m < 4; ++m) { bf16_t* rowp = O + (size_t)(row0 + ai * HALF + m * 16) * ldc + col0;
#pragma unroll
                for (int bj = 0; bj < 2; ++bj) { const f32x4 v0 = acc[ai][bj][m][0], v1 = acc[ai][bj][m][1];
                    u32x4 w; w.x = cvt_pk_bf16(v0[0], v0[1]); w.y = cvt_pk_bf16(v0[2], v0[3]); w.z = cvt_pk_bf16(v1[0], v1[1]); w.w = cvt_pk_bf16(v1[2], v1[3]); *(u32x4*)(rowp + bj * HALF) = w; } }
    }
};
struct EpiF32 {
    static constexpr bool PERM = false, AFTER_DRAIN = false;
    float* O; int ldc;
    __device__ __forceinline__ void operator()(const f32x4 (&acc)[2][2][4][2], const Unit& u, int wr, int wc, int fr, int fq) const {
        const int row0 = u.pm * BM + wr * 64 + fr; const int col0 = u.pn * BM + wc * 32 + 4 * fq;
#pragma unroll
        for (int ai = 0; ai < 2; ++ai)
#pragma unroll
            for (int m = 0; m < 4; ++m) { float* rowp = O + (size_t)(row0 + ai * HALF + m * 16) * ldc + col0;
#pragma unroll
                for (int bj = 0; bj < 2; ++bj)
#pragma unroll
                    for (int n = 0; n < 2; ++n) *(f32x4*)(rowp + bj * HALF + n * 16) = acc[ai][bj][m][n]; }
    }
};

template <class Epi, class Sched, bool ALIGN_EPI = false, bool SP2 = false>
__device__ __forceinline__ void gemm_phase(PG8_LAS unsigned char* lds, const Gemm g, const Sched& S, const Epi& E) {
    int tid_ = threadIdx.x; asm volatile("" : "+v"(tid_)); const int tid = tid_, wid = __builtin_amdgcn_readfirstlane(tid >> 6), lane = tid & 63, wr = wid >> 2, wc = wid & 3, fr = lane & 15, fq = lane >> 4;
    const int K = g.K, nt = K / BK;
    unsigned voffA[2], voffB[2];
#pragma unroll
    for (int i = 0; i < 2; ++i) { int R, C; stage_rc(tid * 16 + i * 8192, R, C); const int Rb = Epi::PERM ? ((R & ~31) + perm32(R & 31)) : R;
        voffA[i] = (unsigned)(R * K + C) * 2u; voffB[i] = (unsigned)(Rb * K + C) * 2u; }
    const size_t kstep = (size_t)(BK * 2);
    const size_t hstep = (size_t)HALF * K * 2;
    const size_t tstep = 2 * hstep;
    const unsigned ldsw = (unsigned)wid * 1024u;
    const int aoff = lds_byte(wr * 64 + fr, fq * 8), boff = lds_byte(wc * 32 + fr, fq * 8);
#define PG8_SA(b, h) (((b) * 2 + (h)) * HTB)
#define PG8_SB(b, h) ((4 + (b) * 2 + (h)) * HTB)
#define PG8_STAGE(bufoff, gbase, voff) do { _Pragma("unroll") for (int _i = 0; _i < 2; ++_i) \
        __builtin_amdgcn_global_load_lds((const unsigned*)((const char*)(gbase) + (voff)[_i]), (PG8_LAS unsigned*)(lds + (bufoff) + ldsw + _i * 8192), 16, 0, 0); } while (0)
#define PG8_LDA(dst, b, h) do { _Pragma("unroll") for (int m = 0; m < 4; ++m) _Pragma("unroll") for (int k = 0; k < 2; ++k) dst[m][k] = *(const PG8_LAS bf16x8*)(lds + PG8_SA(b, h) + aoff + m * 2048 + k * 1024); } while (0)
#define PG8_LDB(dst, b, h) do { _Pragma("unroll") for (int n = 0; n < 2; ++n) _Pragma("unroll") for (int k = 0; k < 2; ++k) dst[n][k] = *(const PG8_LAS bf16x8*)(lds + PG8_SB(b, h) + boff + n * 2048 + k * 1024); } while (0)
#define PG8_MMA(ai, bj, At, Bt) do { __builtin_amdgcn_s_setprio(1); _Pragma("unroll") for (int m = 0; m < 4; ++m) _Pragma("unroll") for (int n = 0; n < 2; ++n) _Pragma("unroll") for (int k = 0; k < 2; ++k) \
        acc[ai][bj][m][n] = __builtin_amdgcn_mfma_f32_16x16x32_bf16(Bt[n][k], At[m][k], acc[ai][bj][m][n], 0, 0, 0); __builtin_amdgcn_s_setprio(0); } while (0)
#define PG8_WAIT_V(n) asm volatile("s_waitcnt vmcnt(" #n ")" ::: "memory")
#define PG8_WAIT_L(n) asm volatile("s_waitcnt lgkmcnt(" #n ")" ::: "memory")
#define PG8_BAR __builtin_amdgcn_s_barrier()
#define PG8_SCHED __builtin_amdgcn_sched_barrier(0)
    Unit cur, nxt; int ui = 0;
    if (!S.next(0, cur)) return;
    f32x4 acc[2][2][4][2];
#pragma unroll
    for (int a = 0; a < 2; ++a)
#pragma unroll
        for (int b = 0; b < 2; ++b)
#pragma unroll
            for (int m = 0; m < 4; ++m)
#pragma unroll
                for (int n = 0; n < 2; ++n) acc[a][b][m][n] = (f32x4){0.f, 0.f, 0.f, 0.f};
    bf16x8 At[4][2], B0[2][2], B1[2][2];
    const char* cA = (const char*)g.A + (size_t)cur.pm * tstep; const char* cB = (const char*)g.Bt + (size_t)cur.pn * tstep;
    S.a_ready(cur);
    if constexpr (SP2) {
        PG8_STAGE(PG8_SB(0, 0), cB, voffB); PG8_STAGE(PG8_SB(0, 1), cB + hstep, voffB); PG8_STAGE(PG8_SA(0, 0), cA, voffA); PG8_STAGE(PG8_SA(0, 1), cA + hstep, voffA);
        if (wr == 1) PG8_BAR;
        PG8_WAIT_V(2); PG8_BAR;
        PG8_STAGE(PG8_SB(1, 0), cB + kstep, voffB); PG8_STAGE(PG8_SA(1, 0), cA + kstep, voffA); PG8_STAGE(PG8_SB(1, 1), cB + hstep + kstep, voffB);
        PG8_WAIT_V(6); PG8_BAR;
    } else {
        PG8_STAGE(PG8_SB(0, 0), cB, voffB); PG8_STAGE(PG8_SA(0, 0), cA, voffA); PG8_STAGE(PG8_SB(0, 1), cB + hstep, voffB); PG8_STAGE(PG8_SA(0, 1), cA + hstep, voffA);
        if (wr == 1) PG8_BAR;
        PG8_WAIT_V(4); PG8_BAR;
        PG8_STAGE(PG8_SB(1, 0), cB + kstep, voffB); PG8_STAGE(PG8_SA(1, 0), cA + kstep, voffA); PG8_STAGE(PG8_SB(1, 1), cB + hstep + kstep, voffB);
        PG8_WAIT_V(6); PG8_BAR;
    }
    for (;;) {
        const bool has_next = S.next(ui + 1, nxt);
        const char* nA = has_next ? (const char*)g.A + (size_t)nxt.pm * tstep : cA; const char* nB = has_next ? (const char*)g.Bt + (size_t)nxt.pn * tstep : cB;
        for (int t = 0; t < nt; t += 2) {
            const bool last = (t == nt - 2);
            const char* a1 = cA + (size_t)(t + 1) * kstep;
            const char* a2 = last ? nA : cA + (size_t)(t + 2) * kstep; const char* b2 = last ? nB : cB + (size_t)(t + 2) * kstep;
            const char* a3 = a2 + kstep; const char* b3 = b2 + kstep;
            if (last && has_next) S.a_ready(nxt);
            if constexpr (SP2) {
            PG8_LDB(B0, 0, 0); PG8_LDB(B1, 0, 1); PG8_SCHED; PG8_LDA(At, 0, 0); PG8_STAGE(PG8_SA(1, 1), a1 + hstep, voffA);
            PG8_WAIT_V(8); PG8_WAIT_L(0); PG8_BAR; PG8_MMA(0, 0, At, B0); PG8_MMA(0, 1, At, B1); PG8_BAR; PG8_SCHED;
            PG8_LDA(At, 0, 1); PG8_STAGE(PG8_SB(0, 0), b2, voffB); PG8_STAGE(PG8_SB(0, 1), b2 + hstep, voffB); PG8_STAGE(PG8_SA(0, 0), a2, voffA);
            PG8_WAIT_V(8); PG8_WAIT_L(0); PG8_BAR; PG8_MMA(1, 0, At, B0); PG8_MMA(1, 1, At, B1); PG8_BAR; PG8_SCHED;
            PG8_LDB(B0, 1, 0); PG8_LDB(B1, 1, 1); PG8_SCHED; PG8_LDA(At, 1, 0); PG8_STAGE(PG8_SA(0, 1), a2 + hstep, voffA);
            PG8_WAIT_V(8); PG8_WAIT_L(0); PG8_BAR; PG8_MMA(0, 0, At, B0); PG8_MMA(0, 1, At, B1); PG8_BAR; PG8_SCHED;
            PG8_LDA(At, 1, 1); PG8_STAGE(PG8_SB(1, 0), b3, voffB); PG8_STAGE(PG8_SB(1, 1), b3 + hstep, voffB); PG8_STAGE(PG8_SA(1, 0), a3, voffA);
            PG8_WAIT_V(8); PG8_WAIT_L(0); PG8_BAR; PG8_MMA(1, 0, At, B0); PG8_MMA(1, 1, At, B1); PG8_BAR; PG8_SCHED;
            } else {
            PG8_LDB(B0, 0, 0); PG8_SCHED; PG8_LDA(At, 0, 0); PG8_STAGE(PG8_SA(1, 1), a1 + hstep, voffA);
            PG8_WAIT_L(8); PG8_BAR; PG8_WAIT_L(0); PG8_MMA(0, 0, At, B0); PG8_BAR; PG8_SCHED;
            PG8_LDB(B1, 0, 1); PG8_STAGE(PG8_SB(0, 0), b2, voffB);
            PG8_BAR; PG8_WAIT_L(0); PG8_MMA(0, 1, At, B1); PG8_BAR;
            PG8_LDA(At, 0, 1); PG8_STAGE(PG8_SA(0, 0), a2, voffA);
            PG8_BAR; PG8_WAIT_L(0); PG8_MMA(1, 0, At, B0); PG8_BAR; PG8_SCHED;
            PG8_STAGE(PG8_SB(0, 1), b2 + hstep, voffB);
            PG8_WAIT_V(6); PG8_BAR; PG8_MMA(1, 1, At, B1); PG8_BAR;
            PG8_LDB(B0, 1, 0); PG8_SCHED; PG8_LDA(At, 1, 0); PG8_STAGE(PG8_SA(0, 1), a2 + hstep, voffA);
            PG8_WAIT_L(8); PG8_BAR; PG8_WAIT_L(0); PG8_MMA(0, 0, At, B0); PG8_BAR; PG8_SCHED;
            PG8_LDB(B1, 1, 1); PG8_STAGE(PG8_SB(1, 0), b3, voffB);
            PG8_BAR; PG8_WAIT_L(0); PG8_MMA(0, 1, At, B1); PG8_BAR;
            PG8_LDA(At, 1, 1); PG8_STAGE(PG8_SA(1, 0), a3, voffA);
            PG8_BAR; PG8_WAIT_L(0); PG8_MMA(1, 0, At, B0); PG8_BAR; PG8_SCHED;
            PG8_STAGE(PG8_SB(1, 1), b3 + hstep, voffB);
            PG8_WAIT_V(6); PG8_BAR; PG8_MMA(1, 1, At, B1); PG8_BAR;
            }
        }
        if constexpr (ALIGN_EPI) { if (wr == 0) PG8_BAR; }
        if constexpr (!Epi::AFTER_DRAIN) { E(acc, cur, wr, wc, fr, fq); S.done(cur); }
        if (!has_next) break;
#pragma unroll
        for (int a = 0; a < 2; ++a)
#pragma unroll
            for (int b = 0; b < 2; ++b)
#pragma unroll
                for (int m = 0; m < 4; ++m)
#pragma unroll
                    for (int n = 0; n < 2; ++n) acc[a][b][m][n] = (f32x4){0.f, 0.f, 0.f, 0.f};
        cur = nxt; cA = nA; cB = nB; ++ui;
        if constexpr (ALIGN_EPI) { if (wr == 1) PG8_BAR; }
    }
    PG8_WAIT_V(0);
    if constexpr (!ALIGN_EPI) { if (wr == 0) PG8_BAR; }
    PG8_BAR;
    if constexpr (Epi::AFTER_DRAIN) { E.fused(acc, cur, wr, wc, fr, fq, lds, wid, lane); S.done(cur); }
#undef PG8_SA
#undef PG8_SB
#undef PG8_STAGE
#undef PG8_LDA
#undef PG8_LDB
#undef PG8_MMA
#undef PG8_WAIT_V
#undef PG8_WAIT_L
#undef PG8_BAR
#undef PG8_SCHED
}
}
#define XB_TMO      128
#define XB_XCNT(j)  (256  + 64 * (j))
#define XB_XSUB(j)  (1280 + 64 * (j))
#define XB_XGEN(j)  (2304 + 64 * (j))
#define XB_TOP      3328
#define XB_TOPGEN   3392
#define XCD_BAR_WORDS 3456
#define XB_SPIN_CAP (1u << 18)

__device__ __forceinline__ unsigned xb_ld(unsigned* p)              { return __hip_atomic_load(p, __ATOMIC_RELAXED, __HIP_MEMORY_SCOPE_AGENT); }
__device__ __forceinline__ unsigned xb_add(unsigned* p, unsigned v) { return __hip_atomic_fetch_add(p, v, __ATOMIC_RELAXED, __HIP_MEMORY_SCOPE_AGENT); }
__device__ __forceinline__ unsigned xb_xcc_id() { return (unsigned)__builtin_amdgcn_s_getreg((3 << 11) | 20) & 0xFu; }
#define XB_SPIN(cond, bar) do { unsigned _sp = 0; while (cond) { __builtin_amdgcn_s_sleep(1); \
    if ((++_sp & 255u) == 0u) { if (xb_ld(&(bar)[XB_TMO])) break; if (_sp > XB_SPIN_CAP) { atomicAdd(&(bar)[XB_TMO], 1u); break; } } } } while (0)

struct XcdBarrier {
    unsigned* bar; unsigned x;
    volatile LAS unsigned* st;
};

__device__ __forceinline__ XcdBarrier xcd_barrier_post(unsigned* bar, volatile LAS unsigned* st) {
    XcdBarrier b; b.bar = bar; b.x = xb_xcc_id(); b.st = st;
    if (threadIdx.x == 0) (void)xb_add(&bar[XB_XCNT(b.x)], 1u);
    return b;
}
__device__ __forceinline__ void xcd_barrier_complete(unsigned* bar, unsigned x, unsigned& nloc, unsigned& nx) {
    const unsigned G = gridDim.x * gridDim.y * gridDim.z;
    unsigned sum, cnt, mine, sp = 0u;
    for (;;) {
        sum = 0u; cnt = 0u; mine = 0u;
#pragma unroll
        for (unsigned j = 0; j < 16; ++j) { const unsigned c = xb_ld(&bar[XB_XCNT(j)]); sum += c; cnt += (c > 0u) ? 1u : 0u; mine = (j == x) ? c : mine; }
        if (sum == G) break;
        __builtin_amdgcn_s_sleep(1);
        if ((++sp & 255u) == 0u) { if (xb_ld(&bar[XB_TMO])) break; if (sp > XB_SPIN_CAP) { atomicAdd(&bar[XB_TMO], 1u); break; } }
    }
    nloc = mine > 0u ? mine : 1u; nx = cnt > 0u ? cnt : 1u;
}

__device__ __forceinline__ void xcd_barrier(const XcdBarrier& b) {
    asm volatile("s_waitcnt vmcnt(0)" ::: "memory");
    __syncthreads();
    if (threadIdx.x == 0) {
        unsigned* bar = b.bar;
        __builtin_amdgcn_s_waitcnt(0);
        unsigned nloc = b.st[0], nx = b.st[1];
        if (nloc == 0u) { xcd_barrier_complete(bar, b.x, nloc, nx); b.st[0] = nloc; b.st[1] = nx; }
        const unsigned old = xb_add(&bar[XB_XSUB(b.x)], 1u);
        const unsigned gen = old / nloc;
        if (old + 1u == (gen + 1u) * nloc) {
            __builtin_amdgcn_fence(__ATOMIC_RELEASE, "agent");
            asm volatile("s_waitcnt vmcnt(0)" ::: "memory");
            const unsigned og = xb_add(&bar[XB_TOP], 1u);
            const unsigned tg = og / nx;
            if (og + 1u == (tg + 1u) * nx) xb_add(&bar[XB_TOPGEN], 1u);
            else XB_SPIN(xb_ld(&bar[XB_TOPGEN]) == tg, bar);
            __builtin_amdgcn_fence(__ATOMIC_ACQUIRE, "agent");
            xb_add(&bar[XB_XGEN(b.x)], 1u);
            asm volatile("s_waitcnt vmcnt(0)" ::: "memory");
        } else {
            XB_SPIN(xb_ld(&bar[XB_XGEN(b.x)]) == gen, bar);
            __builtin_amdgcn_fence(__ATOMIC_ACQUIRE, "agent");
            asm volatile("s_waitcnt vmcnt(0)" ::: "memory");
        }
    }
    __syncthreads();
}

typedef unsigned short bf16;
typedef unsigned v4u __attribute__((ext_vector_type(4)));
typedef unsigned v2u __attribute__((ext_vector_type(2)));
typedef float f32x4 __attribute__((ext_vector_type(4)));
typedef float f32x2 __attribute__((ext_vector_type(2)));
constexpr int NWAVES = 8, NTHR = 512;
constexpr int BATCH = 8, SEQ = 2048, DM = 1024, MTOK = BATCH * SEQ, DEPTH = 4, NMEM = 256, MMEM = BATCH * NMEM;
constexpr int NIN = 3724, NINP = 3840, PP = 3736;
constexpr int P_AQ = 0, P_AK = 256, P_AV = 512, P_AZ = 768, P_BX = 1024, P_BZ = 1280, P_CR = 1536, P_CK = 1792, P_CV = 2048, P_CW = 2304, P_CA = 2368, P_CZ = 2432,
              P_DQ = 2688, P_DK = 2944, P_DV = 3200, P_DZ = 3456, P_G = 3712;
constexpr float NORM_EPS = 1e-6f, GN_EPS = 64e-5f;
constexpr size_t MiB = 1u << 20;
constexpr size_t WS_CTL = 0, CTL_ZERO_BYTES = 1 * MiB;
constexpr size_t WS_WIN = 1 * MiB, WS_WOUT = 9 * MiB, WS_WQ = 11 * MiB, WS_WO = 13 * MiB, WS_WKV = 15 * MiB;
constexpr size_t WS_KV = 19 * MiB;
constexpr size_t WS_MEMN = 27 * MiB;
constexpr size_t WS_BIASP = 254 * MiB;
constexpr size_t WS_BUFA = 31 * MiB;
constexpr size_t WS_BUFP = 63 * MiB;
constexpr size_t WS_GATES = 180 * MiB;
constexpr size_t WS_CUM = 181 * MiB;
constexpr size_t WS_SBON = 181 * MiB + 512 * 1024;
constexpr size_t WS_RREC = 182 * MiB;
constexpr size_t WS_YRAW = 238 * MiB;
constexpr size_t WS_END = 255 * MiB;
static_assert(WS_MEMN + (size_t)MMEM * DM * 2 <= WS_BUFA && WS_BIASP + NINP * 4 <= WS_END, "ws map");
static_assert(WS_BUFP + (size_t)MTOK * PP * 2 <= WS_GATES, "ws map: proj");
constexpr int CW_BAR = 4096;
constexpr int RING_BYTES = 131072, LDSCTL_OFF = RING_BYTES, MISC_OFF = LDSCTL_OFF + 320, LDS_BYTES = 147456;

__device__ __forceinline__ unsigned f2bf(float f) { unsigned u = __builtin_bit_cast(unsigned, f); return (u + 0x7fffu + ((u >> 16) & 1u)) >> 16; }
__device__ __forceinline__ unsigned pk2(float lo, float hi) { return f2bf(lo) | (f2bf(hi) << 16); }
__device__ __forceinline__ float bflo(unsigned w) { return __uint_as_float(w << 16); }
__device__ __forceinline__ float bfhi(unsigned w) { return __uint_as_float(w & 0xffff0000u); }
__device__ __forceinline__ float bf1(bf16 h) { return __uint_as_float((unsigned)h << 16); }
__device__ __forceinline__ float silu_f(float x) { return x / (1.f + __expf(-x)); }
__device__ __forceinline__ float sigmoid_f(float x) { return 1.f / (1.f + __expf(-x)); }
__device__ __forceinline__ float softplus_f(float x) { return fmaxf(x, 0.f) + log1pf(__expf(-fabsf(x))); }
__device__ __forceinline__ float logsigmoid_f(float x) { return fminf(x, 0.f) - log1pf(__expf(-fabsf(x))); }
__device__ __forceinline__ float wave_sum(float v) {
#pragma unroll
    for (int o = 1; o < 64; o <<= 1) v += __shfl_xor(v, o);
    return v;
}
__device__ __forceinline__ float grp16_sum(float v) { v += __shfl_xor(v, 1); v += __shfl_xor(v, 2); v += __shfl_xor(v, 4); v += __shfl_xor(v, 8); return v; }
__device__ __forceinline__ float half_sum(float v) { v += __shfl_xor(v, 1); v += __shfl_xor(v, 2); v += __shfl_xor(v, 4); v += __shfl_xor(v, 8); v += __shfl_xor(v, 16); return v; }
__device__ __forceinline__ void unpack8(const v4u w, float* f) { f[0] = bflo(w.x); f[1] = bfhi(w.x); f[2] = bflo(w.y); f[3] = bfhi(w.y); f[4] = bflo(w.z); f[5] = bfhi(w.z); f[6] = bflo(w.w); f[7] = bfhi(w.w); }

#define CAS __attribute__((address_space(4)))
struct KIn { const CAS unsigned char* kp; __device__ __forceinline__ const GAS float* operator[](int k) const { return (const GAS float*)*(const float* const CAS*)(kp + 8 * k); } };
struct Args {
    const float* in[28]; float* out; unsigned char* ws; int ph_lo, ph_hi, use_cg, pad;
};

#if defined(__HIP_DEVICE_COMPILE__)
__device__ __forceinline__ void rows_norm_bf16(const GAS float* src, GAS bf16* dst, int nrows, int gw, int ngw, int lane) {
    for (int m = gw; m < nrows; m += ngw) {
        const f32x4* xr = (const GAS f32x4*)(src + (size_t)m * DM) + lane; f32x4 v[4]; float s = 0.f;
#pragma unroll
        for (int j = 0; j < 4; ++j) { v[j] = xr[64 * j]; s += (v[j].x * v[j].x + v[j].y * v[j].y) + (v[j].z * v[j].z + v[j].w * v[j].w); }
        const float rstd = 1.f / sqrtf(wave_sum(s) * (1.f / DM) + NORM_EPS);
        v2u* o8 = (GAS v2u*)(dst + (size_t)m * DM) + lane;
#pragma unroll
        for (int j = 0; j < 4; ++j) { v2u w; w.x = pk2(v[j].x * rstd, v[j].y * rstd); w.y = pk2(v[j].z * rstd, v[j].w * rstd); o8[64 * j] = w; }
    }
}
__device__ __forceinline__ void rows_residual(const GAS float* y, const GAS float* xsrc, GAS float* xdst, GAS bf16* xb, const GAS float* gain, int gw, int ngw, int lane) {
    f32x4 g[4];
#pragma unroll
    for (int j = 0; j < 4; ++j) g[j] = ((const GAS f32x4*)gain)[lane + 64 * j];
    for (int m = gw; m < MTOK; m += ngw) {
        const f32x4* yr = (const GAS f32x4*)(y + (size_t)m * DM) + lane; const f32x4* xr = (const GAS f32x4*)(xsrc + (size_t)m * DM) + lane;
        f32x4 v[4], x[4]; float s = 0.f;
#pragma unroll
        for (int j = 0; j < 4; ++j) { v[j] = yr[64 * j]; x[j] = xr[64 * j]; s += (v[j].x * v[j].x + v[j].y * v[j].y) + (v[j].z * v[j].z + v[j].w * v[j].w); }
        const float rstd = 1.f / sqrtf(wave_sum(s) * (1.f / DM) + NORM_EPS);
        float s2 = 0.f;
#pragma unroll
        for (int j = 0; j < 4; ++j) { x[j] = x[j] + v[j] * rstd * g[j]; s2 += (x[j].x * x[j].x + x[j].y * x[j].y) + (x[j].z * x[j].z + x[j].w * x[j].w); }
        const float rstd2 = 1.f / sqrtf(wave_sum(s2) * (1.f / DM) + NORM_EPS);
        f32x4* xo = (GAS f32x4*)(xdst + (size_t)m * DM) + lane; v2u* o8 = (GAS v2u*)(xb + (size_t)m * DM) + lane;
#pragma unroll
        for (int j = 0; j < 4; ++j) { xo[64 * j] = x[j]; v2u w; w.x = pk2(x[j].x * rstd2, x[j].y * rstd2); w.y = pk2(x[j].z * rstd2, x[j].w * rstd2); o8[64 * j] = w; }
    }
}

__device__ __forceinline__ int inmap(int d) { return d < 768 ? d : (d < 3456 ? d + 8 : (d < 3712 ? d + 12 : (d < 3720 ? d - 2944 : (d < 3724 ? d - 256 : -1)))); }
template <bool MAP>
__device__ __forceinline__ void transpose_item(const GAS float* W, int K, int N, GAS bf16* WT, const GAS float* gain, LAS float* scr, int item, int nblk, int lane) {
    const int kb = item / nblk, nb = item % nblk, k0 = 64 * kb, n0 = 32 * nb;
    const int nd = n0 + (lane & 31); const int src = MAP ? inmap(nd) : nd;
#pragma unroll 8
    for (int i = 0; i < 32; ++i) { const int kk = 2 * i + (lane >> 5); float v = 0.f; if (src >= 0) v = W[(size_t)(k0 + kk) * N + src]; if (gain) v *= gain[k0 + kk]; scr[kk * 33 + (lane & 31)] = v; }
    asm volatile("s_waitcnt lgkmcnt(0)" ::: "memory");
    const int c = lane & 7;
#pragma unroll
    for (int j = 0; j < 4; ++j) { const int n = (lane >> 3) + 8 * j; const LAS float* s = scr + (8 * c) * 33 + n;
        v4u o; o.x = pk2(s[0 * 33], s[1 * 33]); o.y = pk2(s[2 * 33], s[3 * 33]); o.z = pk2(s[4 * 33], s[5 * 33]); o.w = pk2(s[6 * 33], s[7 * 33]);
        *(GAS v4u*)(WT + (size_t)(n0 + n) * K + k0 + 8 * c) = o; }
    asm volatile("s_waitcnt lgkmcnt(0)" ::: "memory");
}
__device__ __forceinline__ void phase_convert(const KIn ain, GAS unsigned char* ws, int l, LAS unsigned char* lds, int gw, int ngw, int wave, int lane) {
    LAS float* scr = (LAS float*)(lds + wave * 16384);
        const GAS float* w_in = ain[4] + (size_t)l * DM * NIN; const GAS float* w_out = ain[21] + (size_t)l * DM * DM; const GAS float* wq = ain[25] + (size_t)l * DM * DM;
    const GAS float* wkv = ain[26] + (size_t)l * DM * 2 * DM; const GAS float* wo = ain[27] + (size_t)l * DM * DM;
    const GAS float* g_pre = ain[2] + l * DM; const GAS float* g_xpre = ain[23] + l * DM; const GAS float* g_mem = ain[22];
    constexpr int I_IN = 16 * (NINP / 32), I_SQ = 16 * (DM / 32), I_KV = 16 * (2 * DM / 32);
    constexpr int NITEMS = I_IN + 3 * I_SQ + I_KV;
    for (int it = gw; it < NITEMS; it += ngw) {
        int r = it;
        if (r < I_IN) { transpose_item<true>(w_in, DM, NIN, (GAS bf16*)(ws + WS_WIN), g_pre, scr, r, NINP / 32, lane); continue; } r -= I_IN;
        if (r < I_SQ) { transpose_item<false>(w_out, DM, DM, (GAS bf16*)(ws + WS_WOUT), nullptr, scr, r, DM / 32, lane); continue; } r -= I_SQ;
        if (r < I_SQ) { transpose_item<false>(wq, DM, DM, (GAS bf16*)(ws + WS_WQ), g_xpre, scr, r, DM / 32, lane); continue; } r -= I_SQ;
        if (r < I_SQ) { transpose_item<false>(wo, DM, DM, (GAS bf16*)(ws + WS_WO), nullptr, scr, r, DM / 32, lane); continue; } r -= I_SQ;
        transpose_item<false>(wkv, DM, 2 * DM, (GAS bf16*)(ws + WS_WKV), g_mem, scr, r, 2 * DM / 32, lane);
    }
    const GAS float* b_in = ain[5] + (size_t)l * NIN; float* bp = (GAS float*)(ws + WS_BIASP);
    for (int d = gw * 64 + lane; d < NINP; d += ngw * 64) { const int s = inmap(d); bp[d] = s >= 0 ? b_in[s] : 0.f; }
}

__device__ __forceinline__ void prep_cumsum(const GAS float* gatesT, GAS float* cum, int gw, int ngw, int lane) {
    for (int seq = gw; seq < 64; seq += ngw) {
        const int g = seq >> 3, b = seq & 7; const GAS float* src = gatesT + (size_t)(4 + g) * MTOK + (size_t)b * SEQ + lane * 32; float* dst = cum + (size_t)g * MTOK + (size_t)b * SEQ + lane * 32;
        float v[32]; float run = 0.f;
#pragma unroll
        for (int i = 0; i < 8; ++i) { const f32x4 x = ((const GAS f32x4*)src)[i]; v[4 * i] = logsigmoid_f(x.x); v[4 * i + 1] = logsigmoid_f(x.y); v[4 * i + 2] = logsigmoid_f(x.z); v[4 * i + 3] = logsigmoid_f(x.w); }
#pragma unroll
        for (int i = 0; i < 32; ++i) { run += v[i]; v[i] = run; }
        float tot = run;
#pragma unroll
        for (int o = 1; o < 64; o <<= 1) { const float t = __shfl_up(tot, o); if (lane >= o) tot += t; }
        const float excl = tot - run;
#pragma unroll
        for (int i = 0; i < 8; ++i) { f32x4 x; x.x = v[4 * i] + excl; x.y = v[4 * i + 1] + excl; x.z = v[4 * i + 2] + excl; x.w = v[4 * i + 3] + excl; ((GAS f32x4*)dst)[i] = x; }
    }
}
__device__ __forceinline__ void prep_foxnorm(GAS bf16* proj, const GAS float* qkg, int gw, int ngw, int lane) {
    const int e0 = (lane & 15) * 4;
    float g0[4], g1[4];
#pragma unroll
    for (int e = 0; e < 4; ++e) { g0[e] = qkg[e0 + e] * 0.125f; g1[e] = qkg[64 + e0 + e]; }
    for (int m = gw; m < MTOK; m += ngw) {
        GAS bf16* row = proj + (size_t)m * PP;
        v2u* qp = (GAS v2u*)(row + P_DQ + lane * 4); v2u* kp = (GAS v2u*)(row + P_DK + lane * 4);
        const v2u qw = *qp, kw = *kp;
        float q[4] = {bflo(qw.x), bfhi(qw.x), bflo(qw.y), bfhi(qw.y)}, k[4] = {bflo(kw.x), bfhi(kw.x), bflo(kw.y), bfhi(kw.y)};
        const float sq = grp16_sum(q[0] * q[0] + q[1] * q[1] + q[2] * q[2] + q[3] * q[3]), sk = grp16_sum(k[0] * k[0] + k[1] * k[1] + k[2] * k[2] + k[3] * k[3]);
        const float rq = 1.f / sqrtf(sq * (1.f / 64.f) + NORM_EPS), rk = 1.f / sqrtf(sk * (1.f / 64.f) + NORM_EPS);
        v2u o; o.x = pk2(q[0] * rq * g0[0], q[1] * rq * g0[1]); o.y = pk2(q[2] * rq * g0[2], q[3] * rq * g0[3]); *qp = o;
        o.x = pk2(k[0] * rk * g1[0], k[1] * rk * g1[1]); o.y = pk2(k[2] * rk * g1[2], k[3] * rk * g1[3]); *kp = o;
    }
}
__device__ __forceinline__ void prep_pool(const KIn ain, GAS unsigned char* ws, int l, const GAS bf16* proj, GAS bf16* ybuf, LAS unsigned char* lds, int bid, int nb, int tid) {
    LAS float* pl = (LAS float*)(lds + 16384);
    const GAS float* pw = ain[8] + (size_t)l * 4 * 64 * 64; const GAS float* ps = ain[9] + l * 256;
    const int c = tid & 255, tg = tid >> 8, g = c >> 6, d = c & 63; const int win = 2 << g; const float psc = ps[c];
    for (int it = bid; it < MTOK / 16; it += nb) {
        const int m0 = it * 16 + tg * 8; const int t0 = m0 & (SEQ - 1);
        __syncthreads();
        float vals[23];
#pragma unroll
        for (int i = 0; i < 23; ++i) { const int t = t0 - 15 + i; vals[i] = t >= 0 ? bf1(proj[(size_t)(m0 - 15 + i) * PP + P_BX + c]) : 0.f; }
#pragma unroll
        for (int i = 0; i < 8; ++i) { float s = 0.f;
#pragma unroll
            for (int j = 0; j < 16; ++j) if (j < win) s += vals[15 + i - j];
            const int cnt = min(t0 + i + 1, win); pl[(tg * 8 + i) * 256 + c] = s / (float)cnt - vals[15 + i]; }
        __syncthreads();
        float acc[8];
#pragma unroll
        for (int i = 0; i < 8; ++i) acc[i] = 0.f;
        for (int cc = 0; cc < 64; ++cc) { const float wv = pw[(g * 64 + cc) * 64 + d];
#pragma unroll
            for (int i = 0; i < 8; ++i) acc[i] += pl[(tg * 8 + i) * 256 + g * 64 + cc] * wv; }
#pragma unroll
        for (int i = 0; i < 8; ++i) { const int m = m0 + i; const float z = bf1(proj[(size_t)m * PP + P_BZ + c]); ybuf[(size_t)m * DM + 256 + c] = (bf16)f2bf(acc[i] * psc * silu_f(z)); }
    }
}

__device__ __forceinline__ void mix_mlstm_item(const KIn ain, GAS unsigned char* ws, int l, const GAS bf16* proj, GAS bf16* ybuf, LAS unsigned char* lds, int bh, int qb, int tid) {
        const int b = bh >> 2, h = bh & 3; const int t = qb * 512 + tid; const size_t m = (size_t)b * SEQ + t;
    const GAS float* cw = ain[6] + (size_t)l * 4 * 512;
    const GAS float* gatesT = (const GAS float*)(ws + WS_GATES); const GAS float* cumA = (const GAS float*)(ws + WS_CUM) + (size_t)h * MTOK;
    LAS float* Ks = (LAS float*)lds; LAS float* Vs = (LAS float*)(lds + 16384); LAS float* gs = (LAS float*)(lds + 32768);
    float q[64], acc[64];
#pragma unroll
    for (int d8 = 0; d8 < 8; ++d8) { float s[8];
#pragma unroll
        for (int e = 0; e < 8; ++e) s[e] = 0.f;
#pragma unroll
        for (int j = 0; j < 4; ++j) { const int tt = t - 3 + j; if (tt >= 0) { const v4u w = *(const GAS v4u*)(proj + (m - 3 + j) * PP + P_AQ + h * 64 + d8 * 8); float f[8]; unpack8(w, f);
#pragma unroll
                for (int e = 0; e < 8; ++e) s[e] += f[e] * cw[j * 512 + h * 64 + d8 * 8 + e]; } }
#pragma unroll
        for (int e = 0; e < 8; ++e) q[d8 * 8 + e] = silu_f(s[e]); }
#pragma unroll
    for (int d = 0; d < 64; ++d) acc[d] = 0.f;
    float den = 0.f; const float bt = cumA[m];
    const int skey = tid >> 3, sd0 = (tid & 7) * 8;
    const int nt = (qb * 512 + 512) / 64;
    for (int kt = 0; kt < nt; ++kt) {
        __syncthreads();
        { const int s = kt * 64 + skey; const size_t ms = (size_t)b * SEQ + s; float sk[8];
#pragma unroll
            for (int e = 0; e < 8; ++e) sk[e] = 0.f;
#pragma unroll
            for (int j = 0; j < 4; ++j) { const int tt = s - 3 + j; if (tt >= 0) { const v4u w = *(const GAS v4u*)(proj + (ms - 3 + j) * PP + P_AK + h * 64 + sd0); float f[8]; unpack8(w, f);
#pragma unroll
                    for (int e = 0; e < 8; ++e) sk[e] += f[e] * cw[j * 512 + 256 + h * 64 + sd0 + e]; } }
#pragma unroll
            for (int e = 0; e < 8; ++e) Ks[skey * 64 + sd0 + e] = silu_f(sk[e]) * 0.125f;
            const v4u w = *(const GAS v4u*)(proj + ms * PP + P_AV + h * 64 + sd0); float f[8]; unpack8(w, f);
#pragma unroll
            for (int e = 0; e < 8; ++e) Vs[skey * 64 + sd0 + e] = f[e];
            if (tid < 64) { const size_t mk = (size_t)b * SEQ + kt * 64 + tid; gs[tid] = gatesT[(size_t)h * MTOK + mk] - cumA[mk]; } }
        __syncthreads();
        const int kmax = min(64, t - kt * 64 + 1);
        for (int key = 0; key < kmax; ++key) {
            float dot = 0.f;
#pragma unroll
            for (int d4 = 0; d4 < 16; ++d4) { const f32x4 kv = *(const LAS f32x4*)(Ks + key * 64 + d4 * 4); dot += q[d4 * 4] * kv.x + q[d4 * 4 + 1] * kv.y + q[d4 * 4 + 2] * kv.z + q[d4 * 4 + 3] * kv.w; }
            const float w = dot * __expf(bt + gs[key]); den += w;
#pragma unroll
            for (int d4 = 0; d4 < 16; ++d4) { const f32x4 vv = *(const LAS f32x4*)(Vs + key * 64 + d4 * 4); acc[d4 * 4] += w * vv.x; acc[d4 * 4 + 1] += w * vv.y; acc[d4 * 4 + 2] += w * vv.z; acc[d4 * 4 + 3] += w * vv.w; }
        }
    }
    const float inv = 1.f / fmaxf(fabsf(den), 1.f); float ss = 0.f;
#pragma unroll
    for (int d = 0; d < 64; ++d) { acc[d] *= inv; ss += acc[d] * acc[d]; }
    const float rs = 1.f / sqrtf(ss * (1.f / 64.f) + NORM_EPS);
    const GAS float* ng = ain[7] + l * 256 + h * 64;
#pragma unroll
    for (int d8 = 0; d8 < 8; ++d8) { const v4u zw = *(const GAS v4u*)(proj + m * PP + P_AZ + h * 64 + d8 * 8); float z[8]; unpack8(zw, z); v4u o;
        float y[8];
#pragma unroll
        for (int e = 0; e < 8; ++e) y[e] = acc[d8 * 8 + e] * rs * ng[d8 * 8 + e] * silu_f(z[e]);
        o.x = pk2(y[0], y[1]); o.y = pk2(y[2], y[3]); o.z = pk2(y[4], y[5]); o.w = pk2(y[6], y[7]);
        *(GAS v4u*)(ybuf + m * DM + 0 + h * 64 + d8 * 8) = o; }
}
__device__ __forceinline__ void mix_fox_item(const KIn ain, GAS unsigned char* ws, int l, const GAS bf16* proj, GAS bf16* ybuf, LAS unsigned char* lds, int bh, int qb, int tid) {
        const int b = bh >> 2, h = bh & 3; const int t = qb * 512 + tid; const size_t m = (size_t)b * SEQ + t;
    const GAS float* cumD = (const GAS float*)(ws + WS_CUM) + (size_t)(4 + h) * MTOK;
    LAS float* Ks = (LAS float*)lds; LAS float* Vs = (LAS float*)(lds + 16384); LAS float* gs = (LAS float*)(lds + 32768);
    float q[64], acc[64];
#pragma unroll
    for (int d8 = 0; d8 < 8; ++d8) { const v4u w = *(const GAS v4u*)(proj + m * PP + P_DQ + h * 64 + d8 * 8); unpack8(w, q + d8 * 8); }
#pragma unroll
    for (int d = 0; d < 64; ++d) acc[d] = 0.f;
    float mx = -1e30f, lsum = 0.f; const float ft = cumD[m];
    const int skey = tid >> 3, sd0 = (tid & 7) * 8;
    const int nt = (qb * 512 + 512) / 64;
    for (int kt = 0; kt < nt; ++kt) {
        __syncthreads();
        { const int s = kt * 64 + skey; const size_t ms = (size_t)b * SEQ + s;
            const v4u kw = *(const GAS v4u*)(proj + ms * PP + P_DK + h * 64 + sd0); float f[8]; unpack8(kw, f);
#pragma unroll
            for (int e = 0; e < 8; ++e) Ks[skey * 64 + sd0 + e] = f[e];
            const v4u w = *(const GAS v4u*)(proj + ms * PP + P_DV + h * 64 + sd0); unpack8(w, f);
#pragma unroll
            for (int e = 0; e < 8; ++e) Vs[skey * 64 + sd0 + e] = f[e];
            if (tid < 64) gs[tid] = cumD[(size_t)b * SEQ + kt * 64 + tid]; }
        __syncthreads();
        const int kmax = min(64, t - kt * 64 + 1);
        for (int key = 0; key < kmax; ++key) {
            float dot = 0.f;
#pragma unroll
            for (int d4 = 0; d4 < 16; ++d4) { const f32x4 kv = *(const LAS f32x4*)(Ks + key * 64 + d4 * 4); dot += q[d4 * 4] * kv.x + q[d4 * 4 + 1] * kv.y + q[d4 * 4 + 2] * kv.z + q[d4 * 4 + 3] * kv.w; }
            const float sc = dot + ft - gs[key];
            if (sc > mx) { const float f = __expf(mx - sc); lsum *= f;
#pragma unroll
                for (int d = 0; d < 64; ++d) acc[d] *= f;
                mx = sc; }
            const float p = __expf(sc - mx); lsum += p;
#pragma unroll
            for (int d4 = 0; d4 < 16; ++d4) { const f32x4 vv = *(const LAS f32x4*)(Vs + key * 64 + d4 * 4); acc[d4 * 4] += p * vv.x; acc[d4 * 4 + 1] += p * vv.y; acc[d4 * 4 + 2] += p * vv.z; acc[d4 * 4 + 3] += p * vv.w; }
        }
    }
    const float inv = 1.f / lsum;
#pragma unroll
    for (int d8 = 0; d8 < 8; ++d8) { const v4u zw = *(const GAS v4u*)(proj + m * PP + P_DZ + h * 64 + d8 * 8); float z[8]; unpack8(zw, z); v4u o;
        float y[8];
#pragma unroll
        for (int e = 0; e < 8; ++e) y[e] = acc[d8 * 8 + e] * inv * silu_f(z[e]);
        o.x = pk2(y[0], y[1]); o.y = pk2(y[2], y[3]); o.z = pk2(y[4], y[5]); o.w = pk2(y[6], y[7]);
        *(GAS v4u*)(ybuf + m * DM + 768 + h * 64 + d8 * 8) = o; }
}

typedef short bf16x8 __attribute__((ext_vector_type(8)));
typedef short s16x4 __attribute__((ext_vector_type(4)));
typedef short v4i16_t __attribute__((ext_vector_type(4)));
__device__ __forceinline__ s16x4 ds_tr16(const LAS unsigned char* p) { return __builtin_bit_cast(s16x4, __builtin_amdgcn_ds_read_tr16_b64_v4i16((LAS v4i16_t*)p)); }
__device__ __forceinline__ unsigned cvtpk(float lo, float hi) { typedef float f2_t __attribute__((ext_vector_type(2))); typedef __bf16 b2_t __attribute__((ext_vector_type(2))); f2_t v = {lo, hi}; b2_t b = __builtin_convertvector(v, b2_t); return __builtin_bit_cast(unsigned, b); }
constexpr int TROW = 160;
__device__ __forceinline__ void fox_mfma_item(GAS unsigned char* ws, const GAS bf16* proj, GAS bf16* ybuf, LAS unsigned char* lds, int bh, int qb, int tid) {
    const int b = bh >> 2, h = bh & 3, lane = tid & 63, w = __builtin_amdgcn_readfirstlane(tid >> 6), g = lane >> 4, c16 = lane & 15;
    const GAS float* cumD = (const GAS float*)(ws + WS_CUM) + (size_t)(4 + h) * MTOK + (size_t)b * SEQ;
    const GAS bf16* pb = proj + (size_t)b * SEQ * PP;
    const int q0 = qb * 256, qw0 = q0 + 32 * w;
    LAS unsigned char* Kb = lds; LAS unsigned char* Vb = lds + 2 * 64 * TROW; LAS float* Fb = (LAS float*)(lds + 4 * 64 * TROW);
    bf16x8 qf[2][2]; float ft[2];
#pragma unroll
    for (int qi = 0; qi < 2; ++qi) { const int t = qw0 + 16 * qi + c16; ft[qi] = cumD[t];
#pragma unroll
        for (int s = 0; s < 2; ++s) qf[qi][s] = *(const GAS bf16x8*)(pb + (size_t)t * PP + P_DQ + h * 64 + 32 * s + 8 * g); }
    f32x4 o[4][2];
#pragma unroll
    for (int n = 0; n < 4; ++n) { o[n][0] = (f32x4){0.f, 0.f, 0.f, 0.f}; o[n][1] = (f32x4){0.f, 0.f, 0.f, 0.f}; }
    float mx[2] = {-1e30f, -1e30f}, ls[2] = {0.f, 0.f};
    const int nkt = 4 * (qb + 1);
    const int sr = tid >> 3, sc8 = (tid & 7) * 8;
    __syncthreads();
    { const GAS bf16* rowp = pb + (size_t)sr * PP + h * 64 + sc8;
      *(LAS v4u*)(Kb + sr * TROW + sc8 * 2) = *(const GAS v4u*)(rowp + P_DK); *(LAS v4u*)(Vb + sr * TROW + sc8 * 2) = *(const GAS v4u*)(rowp + P_DV);
      if (tid < 64) Fb[tid] = cumD[tid]; }
    __syncthreads();
    for (int kt = 0; kt < nkt; ++kt) {
        const int cur = kt & 1; const bool more = kt + 1 < nkt;
        v4u kreg, vreg; float freg = 0.f;
        if (more) { const GAS bf16* rowp = pb + (size_t)(64 * (kt + 1) + sr) * PP + h * 64 + sc8; kreg = *(const GAS v4u*)(rowp + P_DK); vreg = *(const GAS v4u*)(rowp + P_DV); if (tid < 64) freg = cumD[64 * (kt + 1) + tid]; }
        if (64 * kt <= qw0 + 31) {
            const LAS unsigned char* Kc = Kb + cur * 64 * TROW; const LAS unsigned char* Vc = Vb + cur * 64 * TROW; const LAS float* Fc = Fb + cur * 64;
            f32x4 sacc[4][2];
#pragma unroll
            for (int n = 0; n < 4; ++n) {
                const bf16x8 k0 = *(const LAS bf16x8*)(Kc + (16 * n + c16) * TROW + (8 * g) * 2), k1 = *(const LAS bf16x8*)(Kc + (16 * n + c16) * TROW + (32 + 8 * g) * 2);
#pragma unroll
                for (int qi = 0; qi < 2; ++qi) { f32x4 z = (f32x4){0.f, 0.f, 0.f, 0.f}; z = __builtin_amdgcn_mfma_f32_16x16x32_bf16(k0, qf[qi][0], z, 0, 0, 0); sacc[n][qi] = __builtin_amdgcn_mfma_f32_16x16x32_bf16(k1, qf[qi][1], z, 0, 0, 0); } }
            const bool diag = (64 * kt + 63 > qw0);
            f32x4 fs[4];
#pragma unroll
            for (int n = 0; n < 4; ++n) fs[n] = *(const LAS f32x4*)(Fc + 16 * n + 4 * g);
#pragma unroll
            for (int qi = 0; qi < 2; ++qi) {
                const int tq = qw0 + 16 * qi + c16; float rm = -1e30f;
#pragma unroll
                for (int n = 0; n < 4; ++n)
#pragma unroll
                    for (int j = 0; j < 4; ++j) { float sc = sacc[n][qi][j] + (ft[qi] - fs[n][j]); if (diag && (64 * kt + 16 * n + 4 * g + j > tq)) sc = -1e30f; sacc[n][qi][j] = sc; rm = fmaxf(rm, sc); }
                rm = fmaxf(rm, __shfl_xor(rm, 16)); rm = fmaxf(rm, __shfl_xor(rm, 32));
                const float mnew = fmaxf(mx[qi], rm); const float alpha = __expf(mx[qi] - mnew); mx[qi] = mnew;
                float psum = 0.f;
#pragma unroll
                for (int n = 0; n < 4; ++n)
#pragma unroll
                    for (int j = 0; j < 4; ++j) { const float p = __expf(sacc[n][qi][j] - mnew); sacc[n][qi][j] = p; psum += p; }
                ls[qi] = ls[qi] * alpha + psum;
#pragma unroll
                for (int n = 0; n < 4; ++n) o[n][qi] = o[n][qi] * alpha;
            }
            bf16x8 pf[2][2];
#pragma unroll
            for (int qi = 0; qi < 2; ++qi)
#pragma unroll
                for (int s = 0; s < 2; ++s) { v4u pw; pw.x = cvtpk(sacc[2 * s][qi][0], sacc[2 * s][qi][1]); pw.y = cvtpk(sacc[2 * s][qi][2], sacc[2 * s][qi][3]); pw.z = cvtpk(sacc[2 * s + 1][qi][0], sacc[2 * s + 1][qi][1]); pw.w = cvtpk(sacc[2 * s + 1][qi][2], sacc[2 * s + 1][qi][3]); pf[qi][s] = __builtin_bit_cast(bf16x8, pw); }
            const int tq4 = c16 >> 2, tp = c16 & 3;
#pragma unroll
            for (int n = 0; n < 4; ++n)
#pragma unroll
                for (int s = 0; s < 2; ++s) { const LAS unsigned char* a1 = Vc + (32 * s + 4 * g + tq4) * TROW + (16 * n + 4 * tp) * 2;
                    const s16x4 lo = ds_tr16(a1), hi = ds_tr16(a1 + 16 * TROW);
                    const bf16x8 vf = (bf16x8){lo[0], lo[1], lo[2], lo[3], hi[0], hi[1], hi[2], hi[3]};
                    o[n][0] = __builtin_amdgcn_mfma_f32_16x16x32_bf16(vf, pf[0][s], o[n][0], 0, 0, 0); o[n][1] = __builtin_amdgcn_mfma_f32_16x16x32_bf16(vf, pf[1][s], o[n][1], 0, 0, 0); }
        }
        if (more) { const int nx = cur ^ 1; *(LAS v4u*)(Kb + nx * 64 * TROW + sr * TROW + sc8 * 2) = kreg; *(LAS v4u*)(Vb + nx * 64 * TROW + sr * TROW + sc8 * 2) = vreg; if (tid < 64) Fb[nx * 64 + tid] = freg; }
        __syncthreads();
    }
#pragma unroll
    for (int qi = 0; qi < 2; ++qi) {
        float l = ls[qi]; l += __shfl_xor(l, 16); l += __shfl_xor(l, 32); const float inv = 1.f / l;
        const size_t m = (size_t)b * SEQ + qw0 + 16 * qi + c16;
#pragma unroll
        for (int n = 0; n < 4; ++n) { const v2u zw = *(const GAS v2u*)(proj + m * PP + P_DZ + h * 64 + 16 * n + 4 * g);
            v2u ow; ow.x = pk2(o[n][qi][0] * inv * silu_f(bflo(zw.x)), o[n][qi][1] * inv * silu_f(bfhi(zw.x))); ow.y = pk2(o[n][qi][2] * inv * silu_f(bflo(zw.y)), o[n][qi][3] * inv * silu_f(bfhi(zw.y)));
            *(GAS v2u*)(ybuf + m * DM + 768 + h * 64 + 16 * n + 4 * g) = ow; }
    }
}

constexpr int ML_TILE = 64 * TROW;
constexpr int ML_Q = 0, ML_K = 2 * ML_TILE, ML_V = 4 * ML_TILE, ML_VW = 6 * ML_TILE, ML_C = 8 * ML_TILE, ML_SM = 10 * ML_TILE;
constexpr int SM_AS = 0, SM_BC = 64, SM_WS = 128, SM_N = 192, SM_SS = 256, SM_EG = 384, SM_STRIDE = 512, SM_CW = 2 * SM_STRIDE;
__device__ __forceinline__ void mlstm_item(const KIn ain, GAS unsigned char* ws, int l, const GAS bf16* proj, GAS bf16* ybuf, LAS unsigned char* lds, int bh, int tid) {
    const int b = bh >> 2, h = bh & 3, lane = tid & 63, w = __builtin_amdgcn_readfirstlane(tid >> 6), g = lane >> 4, c16 = lane & 15;
    const int rt = w & 3, hv = w >> 2;
    const GAS float* cumA = (const GAS float*)(ws + WS_CUM) + (size_t)h * MTOK + (size_t)b * SEQ; const GAS float* gi = (const GAS float*)(ws + WS_GATES) + (size_t)h * MTOK + (size_t)b * SEQ;
    const GAS bf16* pb = proj + (size_t)b * SEQ * PP;
    LAS float* sm = (LAS float*)(lds + ML_SM);
    const int sr = tid >> 3, sc8 = (tid & 7) * 8;
    __syncthreads();
    { const GAS float* cw = ain[6] + (size_t)l * 4 * 512; const int j = tid >> 7, c = tid & 127; sm[SM_CW + tid] = cw[j * 512 + (c < 64 ? h * 64 + c : 256 + h * 64 + (c - 64))];
      for (int u = tid; u < ML_TILE / 4; u += NTHR) ((LAS unsigned*)(lds + ML_C))[u] = 0u;
      if (tid < 64) sm[SM_N + tid] = 0.f; }
    f32x4 X[2] = {(f32x4){0.f, 0.f, 0.f, 0.f}, (f32x4){0.f, 0.f, 0.f, 0.f}};
    v4u qraw[4], kraw[4], vraw; float cum_r, ig_r, cum_end, cum_prev, cum_s = 0.f, ig_s = 0.f;
#define ML_LOAD(cc) do { const int t0_ = 64 * (cc); const int tr_ = t0_ + sr; \
        _Pragma("unroll") for (int j = 0; j < 4; ++j) { const int tt = tr_ - 3 + j; if (tt >= 0) { qraw[j] = *(const GAS v4u*)(pb + (size_t)tt * PP + P_AQ + h * 64 + sc8); kraw[j] = *(const GAS v4u*)(pb + (size_t)tt * PP + P_AK + h * 64 + sc8); } \
            else { qraw[j] = (v4u){0u, 0u, 0u, 0u}; kraw[j] = (v4u){0u, 0u, 0u, 0u}; } } \
        vraw = *(const GAS v4u*)(pb + (size_t)tr_ * PP + P_AV + h * 64 + sc8); cum_r = cumA[tr_]; ig_r = gi[tr_]; cum_end = cumA[t0_ + 63]; cum_prev = t0_ > 0 ? cumA[t0_ - 1] : 0.f; \
        if (tid < 64) { cum_s = cumA[t0_ + tid]; ig_s = gi[t0_ + tid]; } } while (0)
#define ML_STORE(buf) do { LAS unsigned char* Qd = lds + ML_Q + (buf) * ML_TILE + sr * TROW + sc8 * 2; LAS unsigned char* Kd = lds + ML_K + (buf) * ML_TILE + sr * TROW + sc8 * 2; \
        LAS unsigned char* Vd = lds + ML_V + (buf) * ML_TILE + sr * TROW + sc8 * 2; LAS unsigned char* Wd = lds + ML_VW + (buf) * ML_TILE + sr * TROW + sc8 * 2; \
        float aq[8], ak[8]; _Pragma("unroll") for (int e = 0; e < 8; ++e) { aq[e] = 0.f; ak[e] = 0.f; } \
        _Pragma("unroll") for (int j = 0; j < 4; ++j) { float fq_[8], fk_[8]; unpack8(qraw[j], fq_); unpack8(kraw[j], fk_); \
            const f32x4 wq0 = *(const LAS f32x4*)(sm + SM_CW + j * 128 + sc8), wq1 = *(const LAS f32x4*)(sm + SM_CW + j * 128 + sc8 + 4), wk0 = *(const LAS f32x4*)(sm + SM_CW + j * 128 + 64 + sc8), wk1 = *(const LAS f32x4*)(sm + SM_CW + j * 128 + 64 + sc8 + 4); \
            aq[0] += fq_[0] * wq0.x; aq[1] += fq_[1] * wq0.y; aq[2] += fq_[2] * wq0.z; aq[3] += fq_[3] * wq0.w; aq[4] += fq_[4] * wq1.x; aq[5] += fq_[5] * wq1.y; aq[6] += fq_[6] * wq1.z; aq[7] += fq_[7] * wq1.w; \
            ak[0] += fk_[0] * wk0.x; ak[1] += fk_[1] * wk0.y; ak[2] += fk_[2] * wk0.z; ak[3] += fk_[3] * wk0.w; ak[4] += fk_[4] * wk1.x; ak[5] += fk_[5] * wk1.y; ak[6] += fk_[6] * wk1.z; ak[7] += fk_[7] * wk1.w; } \
        _Pragma("unroll") for (int e = 0; e < 8; ++e) { aq[e] = silu_f(aq[e]); ak[e] = silu_f(ak[e]) * 0.125f; } \
        v4u t_; t_.x = cvtpk(aq[0], aq[1]); t_.y = cvtpk(aq[2], aq[3]); t_.z = cvtpk(aq[4], aq[5]); t_.w = cvtpk(aq[6], aq[7]); *(LAS v4u*)Qd = t_; \
        t_.x = cvtpk(ak[0], ak[1]); t_.y = cvtpk(ak[2], ak[3]); t_.z = cvtpk(ak[4], ak[5]); t_.w = cvtpk(ak[6], ak[7]); *(LAS v4u*)Kd = t_; \
        *(LAS v4u*)Vd = vraw; { float fv_[8]; unpack8(vraw, fv_); const float wr_ = __expf(cum_end - cum_r + ig_r); \
            t_.x = cvtpk(fv_[0] * wr_, fv_[1] * wr_); t_.y = cvtpk(fv_[2] * wr_, fv_[3] * wr_); t_.z = cvtpk(fv_[4] * wr_, fv_[5] * wr_); t_.w = cvtpk(fv_[6] * wr_, fv_[7] * wr_); *(LAS v4u*)Wd = t_; } \
        if (tid < 64) { LAS float* s_ = sm + (buf) * SM_STRIDE; const float bc_ = cum_s - cum_prev; s_[SM_AS + tid] = ig_s - bc_; s_[SM_BC + tid] = bc_; s_[SM_WS + tid] = __expf(cum_end - cum_s + ig_s); if (tid == 0) s_[SM_EG] = __expf(cum_end - cum_prev); } } while (0)
    ML_LOAD(0);
    __syncthreads();
    ML_STORE(0);
    __syncthreads();
    const GAS float* ng = ain[7] + l * 256 + h * 64;
    for (int c = 0; c < SEQ / 64; ++c) {
        const int cur = c & 1, nx = cur ^ 1; const bool more = c + 1 < SEQ / 64;
        if (more) ML_LOAD(c + 1);
        const LAS unsigned char* Qc = lds + ML_Q + cur * ML_TILE; const LAS unsigned char* Kc = lds + ML_K + cur * ML_TILE; const LAS unsigned char* Vc = lds + ML_V + cur * ML_TILE; const LAS unsigned char* Wc = lds + ML_VW + cur * ML_TILE;
        const LAS unsigned char* Cc = lds + ML_C + cur * ML_TILE; LAS unsigned char* Cn = lds + ML_C + nx * ML_TILE;
        const LAS float* sc_ = sm + cur * SM_STRIDE; LAS float* sn_ = sm + nx * SM_STRIDE;
        const size_t mq = (size_t)b * SEQ + 64 * c + 16 * rt + c16;
        v2u zw[2];
#pragma unroll
        for (int n = 0; n < 2; ++n) zw[n] = *(const GAS v2u*)(proj + mq * PP + P_AZ + h * 64 + 16 * (2 * hv + n) + 4 * g);
        const bf16x8 qf0 = *(const LAS bf16x8*)(Qc + (16 * rt + c16) * TROW + (8 * g) * 2), qf1 = *(const LAS bf16x8*)(Qc + (16 * rt + c16) * TROW + (32 + 8 * g) * 2);
        const float bct = sc_[SM_BC + 16 * rt + c16];
        f32x4 sacc[4];
#pragma unroll
        for (int n = 0; n < 4; ++n) { sacc[n] = (f32x4){0.f, 0.f, 0.f, 0.f};
            if (n <= rt) { const bf16x8 k0 = *(const LAS bf16x8*)(Kc + (16 * n + c16) * TROW + (8 * g) * 2), k1 = *(const LAS bf16x8*)(Kc + (16 * n + c16) * TROW + (32 + 8 * g) * 2);
                f32x4 z = __builtin_amdgcn_mfma_f32_16x16x32_bf16(k0, qf0, sacc[n], 0, 0, 0); sacc[n] = __builtin_amdgcn_mfma_f32_16x16x32_bf16(k1, qf1, z, 0, 0, 0); } }
        float den = 0.f;
#pragma unroll
        for (int n = 0; n < 4; ++n) { const f32x4 as = *(const LAS f32x4*)(sc_ + SM_AS + 16 * n + 4 * g);
#pragma unroll
            for (int j = 0; j < 4; ++j) { const bool vis = (n < rt) || (n == rt && (4 * g + j <= c16)); const float p = vis ? sacc[n][j] * __expf(bct + as[j]) : 0.f; sacc[n][j] = p; den += p; } }
        bf16x8 pf[2];
#pragma unroll
        for (int s = 0; s < 2; ++s) { v4u pw; pw.x = cvtpk(sacc[2 * s][0], sacc[2 * s][1]); pw.y = cvtpk(sacc[2 * s][2], sacc[2 * s][3]); pw.z = cvtpk(sacc[2 * s + 1][0], sacc[2 * s + 1][1]); pw.w = cvtpk(sacc[2 * s + 1][2], sacc[2 * s + 1][3]); pf[s] = __builtin_bit_cast(bf16x8, pw); }
        const int tq4 = c16 >> 2, tp = c16 & 3;
        f32x4 o[2], xi[2];
#pragma unroll
        for (int n = 0; n < 2; ++n) { const int nd = 2 * hv + n; o[n] = (f32x4){0.f, 0.f, 0.f, 0.f}; xi[n] = (f32x4){0.f, 0.f, 0.f, 0.f};
#pragma unroll
            for (int s = 0; s < 2; ++s) { const LAS unsigned char* a1 = Vc + (32 * s + 4 * g + tq4) * TROW + (16 * nd + 4 * tp) * 2; const s16x4 lo = ds_tr16(a1), hi = ds_tr16(a1 + 16 * TROW);
                const bf16x8 vf = (bf16x8){lo[0], lo[1], lo[2], lo[3], hi[0], hi[1], hi[2], hi[3]};
                o[n] = __builtin_amdgcn_mfma_f32_16x16x32_bf16(vf, pf[s], o[n], 0, 0, 0);
                const bf16x8 cf = *(const LAS bf16x8*)(Cc + (16 * nd + c16) * TROW + (32 * s + 8 * g) * 2);
                xi[n] = __builtin_amdgcn_mfma_f32_16x16x32_bf16(cf, s == 0 ? qf0 : qf1, xi[n], 0, 0, 0); } }
        float nq = 0.f;
        { float f0[8], f1[8]; unpack8(__builtin_bit_cast(v4u, qf0), f0); unpack8(__builtin_bit_cast(v4u, qf1), f1);
          const f32x4 n0 = *(const LAS f32x4*)(sc_ + SM_N + 8 * g), n1 = *(const LAS f32x4*)(sc_ + SM_N + 8 * g + 4), n2 = *(const LAS f32x4*)(sc_ + SM_N + 32 + 8 * g), n3 = *(const LAS f32x4*)(sc_ + SM_N + 32 + 8 * g + 4);
          nq = f0[0] * n0.x + f0[1] * n0.y + f0[2] * n0.z + f0[3] * n0.w + f0[4] * n1.x + f0[5] * n1.y + f0[6] * n1.z + f0[7] * n1.w
             + f1[0] * n2.x + f1[1] * n2.y + f1[2] * n2.z + f1[3] * n2.w + f1[4] * n3.x + f1[5] * n3.y + f1[6] * n3.z + f1[7] * n3.w; }
        const float ebt = __expf(bct);
        float dtot = den + ebt * nq; dtot += __shfl_xor(dtot, 16); dtot += __shfl_xor(dtot, 32);
        const float dinv = 1.f / fmaxf(fabsf(dtot), 1.f);
        float ssq = 0.f;
#pragma unroll
        for (int n = 0; n < 2; ++n) { o[n] = (o[n] + xi[n] * ebt) * dinv; ssq += o[n][0] * o[n][0] + o[n][1] * o[n][1] + o[n][2] * o[n][2] + o[n][3] * o[n][3]; }
        ssq += __shfl_xor(ssq, 16); ssq += __shfl_xor(ssq, 32);
        if (g == 0) sn_[SM_SS + hv * 64 + 16 * rt + c16] = ssq;
        { const float eg = sc_[SM_EG]; const int et = w & 3;
          bf16x8 ktf[2];
#pragma unroll
          for (int s = 0; s < 2; ++s) { const LAS unsigned char* a1 = Kc + (32 * s + 4 * g + tq4) * TROW + (16 * et + 4 * tp) * 2; const s16x4 lo = ds_tr16(a1), hi = ds_tr16(a1 + 16 * TROW);
              ktf[s] = (bf16x8){lo[0], lo[1], lo[2], lo[3], hi[0], hi[1], hi[2], hi[3]}; }
#pragma unroll
          for (int n = 0; n < 2; ++n) { const int dt = 2 * hv + n; X[n] = X[n] * eg;
#pragma unroll
              for (int s = 0; s < 2; ++s) { const LAS unsigned char* a1 = Wc + (32 * s + 4 * g + tq4) * TROW + (16 * dt + 4 * tp) * 2; const s16x4 lo = ds_tr16(a1), hi = ds_tr16(a1 + 16 * TROW);
                  const bf16x8 wf = (bf16x8){lo[0], lo[1], lo[2], lo[3], hi[0], hi[1], hi[2], hi[3]};
                  X[n] = __builtin_amdgcn_mfma_f32_16x16x32_bf16(ktf[s], wf, X[n], 0, 0, 0); }
              v2u cw; cw.x = cvtpk(X[n][0], X[n][1]); cw.y = cvtpk(X[n][2], X[n][3]); *(LAS v2u*)(Cn + (16 * dt + c16) * TROW + (16 * et + 4 * g) * 2) = cw; }
          if (hv == 0) {
              float acc = 0.f;
#pragma unroll
              for (int i = 0; i < 16; ++i) { const int s = 16 * g + i; acc += sc_[SM_WS + s] * bf1(*(const LAS bf16*)(Kc + s * TROW + (16 * et + c16) * 2)); }
              acc += __shfl_xor(acc, 16); acc += __shfl_xor(acc, 32);
              if (g == 0) sn_[SM_N + 16 * et + c16] = eg * sc_[SM_N + 16 * et + c16] + acc; } }
        if (more) ML_STORE(nx);
        __syncthreads();
        { const float tot = sn_[SM_SS + 16 * rt + c16] + sn_[SM_SS + 64 + 16 * rt + c16]; const float rs = 1.f / sqrtf(tot * (1.f / 64.f) + NORM_EPS);
#pragma unroll
          for (int n = 0; n < 2; ++n) { const int d0 = 16 * (2 * hv + n) + 4 * g; const f32x4 gn = *(const GAS f32x4*)(ng + d0);
              v2u ow; ow.x = pk2(o[n][0] * rs * gn.x * silu_f(bflo(zw[n].x)), o[n][1] * rs * gn.y * silu_f(bfhi(zw[n].x))); ow.y = pk2(o[n][2] * rs * gn.z * silu_f(bflo(zw[n].y)), o[n][3] * rs * gn.w * silu_f(bfhi(zw[n].y)));
              *(GAS v2u*)(ybuf + mq * DM + h * 64 + d0) = ow; } }
    }
#undef ML_LOAD
#undef ML_STORE
}
constexpr int RC_KT = 0, RC_RT = 2176, RC_KB = 4352, RC_VT = 8960, RC_A34 = 11520, RC_A2 = 12672, RC_MM = 13312, RC_GM = 13952, RC_USED = 14208, RC_SIZE = 14336;
constexpr int RC_P64 = 136, RC_P32 = 72, RC_P16 = 40;
constexpr int PL_LO = 0, PL_LW = 8192, PL_KK = PL_LW + 16384, PL_BB = PL_KK + 16384, PL_K2 = PL_BB + 16384, PL_RR = PL_K2 + 16384, PL_TK = PL_RR + 16384, PL_TR = PL_TK + 9216, PL_TB = PL_TR + 9216, PL_TQ = PL_TB + 9216, PL_A1 = PL_TQ + 9216, PL_END = PL_A1 + 4096, PLP = 144, PLH = 16 * PLP;
static_assert(PL_END <= RING_BYTES, "prep LDS map");
__device__ __forceinline__ void prep_rwkv(const KIn ain, GAS unsigned char* ws, int l, const GAS bf16* proj, LAS unsigned char* lds, int bid, int nb, int tid) {
    LAS float* lo = (LAS float*)(lds + PL_LO);
    LAS float* LW = (LAS float*)(lds + PL_LW); LAS float* KK = (LAS float*)(lds + PL_KK); LAS float* BB = (LAS float*)(lds + PL_BB); LAS float* K2 = (LAS float*)(lds + PL_K2); LAS float* RR = (LAS float*)(lds + PL_RR);
    const GAS float* mu = ain[10] + l * 896; const GAS float* w0 = ain[11] + l * 256; const GAS float* w2 = ain[12] + (size_t)l * 64 * 256; const GAS float* a0 = ain[13] + l * 256; const GAS float* a2 = ain[14] + (size_t)l * 64 * 256;
    const GAS float* key_k = ain[15] + l * 256; const GAS float* key_a = ain[16] + l * 256; const GAS float* bonus_u = ain[17] + l * 256;
    GAS unsigned char* rrec = ws + WS_RREC; GAS float* sbon = (GAS float*)(ws + WS_SBON);
    const int c = tid & 255, tg = tid >> 8, lane = tid & 63, hh = c >> 6, e = c & 63, w = __builtin_amdgcn_readfirstlane(tid >> 6), g = lane >> 4, c16 = lane & 15;
    const float mur = mu[c], muk = mu[256 + c], muv = mu[512 + c], w0c = w0[c], a0c = a0[c], kkc = key_k[c], kac = key_a[c], buc = bonus_u[c];
    for (int it = bid; it < MTOK / 16; it += nb) {
        const int m0 = it * 16; const int bb_ = m0 >> 11, ch = (m0 & (SEQ - 1)) >> 4;
        GAS unsigned char* rec = rrec + ((size_t)(bb_ * 4 + hh) * (SEQ / 16) + ch) * RC_SIZE;
        __syncthreads();
#pragma unroll
        for (int i = 0; i < 4; ++i) { const int idx = tid + 512 * i, tok = idx >> 7, j = idx & 127; const int m = m0 + tok; const int t = m & (SEQ - 1);
            const float cur = bf1(proj[(size_t)m * PP + P_CW + j]); const float prev = t > 0 ? bf1(proj[(size_t)(m - 1) * PP + P_CW + j]) : 0.f;
            float v = cur + mu[768 + j] * (prev - cur); if (j < 64) v = tanhf(v); lo[tok * 128 + j] = v; }
        __syncthreads();
        float accw[8], acca[8];
#pragma unroll
        for (int i = 0; i < 8; ++i) { accw[i] = 0.f; acca[i] = 0.f; }
        for (int j = 0; j < 64; ++j) { const float w2v = w2[j * 256 + c], a2v = a2[j * 256 + c];
#pragma unroll
            for (int i = 0; i < 8; ++i) { accw[i] += lo[(tg * 8 + i) * 128 + j] * w2v; acca[i] += lo[(tg * 8 + i) * 128 + 64 + j] * a2v; } }
        float vv[8];
#pragma unroll
        for (int i = 0; i < 8; ++i) { const int tok = tg * 8 + i; const int m = m0 + tok; const int t = m & (SEQ - 1); const GAS bf16* row = proj + (size_t)m * PP; const GAS bf16* prow = row - PP;
            const float cr = bf1(row[P_CR + c]), ck = bf1(row[P_CK + c]), cv = bf1(row[P_CV + c]);
            const float pr = t > 0 ? bf1(prow[P_CR + c]) : 0.f, pk = t > 0 ? bf1(prow[P_CK + c]) : 0.f, pv = t > 0 ? bf1(prow[P_CV + c]) : 0.f;
            const float r = cr + mur * (pr - cr), k = ck + muk * (pk - ck), v = cv + muv * (pv - cv);
            const float wl = -softplus_f(-(w0c + accw[i])) - 0.5f; const float lwv = -__expf(wl);
            const float av = sigmoid_f(a0c + acca[i]);
            const float kkv = k * kkc; const float ss = wave_sum(kkv * kkv); const float kkn = kkv / fmaxf(sqrtf(ss), 1e-12f);
            const float k2 = k * (1.f + (av - 1.f) * kac); const float bbv = kkn * av;
            const float sb = wave_sum(r * k2 * buc);
            LW[tok * 256 + c] = lwv; KK[tok * 256 + c] = kkn; BB[tok * 256 + c] = bbv; K2[tok * 256 + c] = k2; RR[tok * 256 + c] = r; vv[i] = v;
            if (lane == 0) sbon[(size_t)m * 4 + hh] = sb; }
        { v4u o; o.x = pk2(vv[0], vv[1]); o.y = pk2(vv[2], vv[3]); o.z = pk2(vv[4], vv[5]); o.w = pk2(vv[6], vv[7]); *(GAS v4u*)(rec + RC_VT + e * RC_P16 + tg * 16) = o; }
        __syncthreads();
        { float cum[16]; float run = 0.f;
#pragma unroll
          for (int t = 0; t < 16; ++t) { run += LW[t * 256 + c]; cum[t] = run; }
          const float ltot = run; float kh[8], bh[8];
          LAS unsigned char* tk = lds + PL_TK + hh * PLH; LAS unsigned char* tr = lds + PL_TR + hh * PLH; LAS unsigned char* tb = lds + PL_TB + hh * PLH; LAS unsigned char* tq = lds + PL_TQ + hh * PLH;
#pragma unroll
          for (int i = 0; i < 8; ++i) {
              float lg = 0.f, lgm = 0.f;
#pragma unroll
              for (int t = 0; t < 16; ++t) { if (t == tg * 8 + i) lg = cum[t]; if (t + 1 == tg * 8 + i) lgm = cum[t]; }
              const int tok = tg * 8 + i;
              const float eg = __expf(lg), egm = __expf(lgm), einv = __expf(-lg), eh = __expf(ltot - lg);
              const float kkn = KK[tok * 256 + c], bbv = BB[tok * 256 + c], k2 = K2[tok * 256 + c], r = RR[tok * 256 + c];
              const bf16 ktv = (bf16)f2bf(kkn * egm), rtv = (bf16)f2bf(r * eg), btv = (bf16)f2bf(bbv * einv), kqv = (bf16)f2bf(k2 * einv);
              *(LAS bf16*)(tk + tok * PLP + e * 2) = ktv; *(LAS bf16*)(tr + tok * PLP + e * 2) = rtv; *(LAS bf16*)(tb + tok * PLP + e * 2) = btv; *(LAS bf16*)(tq + tok * PLP + e * 2) = kqv;
              *(GAS bf16*)(rec + RC_KT + tok * RC_P64 + e * 2) = ktv; *(GAS bf16*)(rec + RC_RT + tok * RC_P64 + e * 2) = rtv;
              kh[i] = k2 * eh; bh[i] = -bbv * eh; }
          v4u o; o.x = pk2(kh[0], kh[1]); o.y = pk2(kh[2], kh[3]); o.z = pk2(kh[4], kh[5]); o.w = pk2(kh[6], kh[7]); *(GAS v4u*)(rec + RC_KB + e * RC_P32 + tg * 16) = o;
          o.x = pk2(bh[0], bh[1]); o.y = pk2(bh[2], bh[3]); o.z = pk2(bh[4], bh[5]); o.w = pk2(bh[6], bh[7]); *(GAS v4u*)(rec + RC_KB + e * RC_P32 + 32 + tg * 16) = o;
          if (tg == 0) *(GAS float*)(rec + RC_GM + e * 4) = __expf(ltot); }
        __syncthreads();
        { const int hd = w & 3, hf = w >> 2; GAS unsigned char* rech = rrec + ((size_t)(bb_ * 4 + hd) * (SEQ / 16) + ch) * RC_SIZE;
          const LAS unsigned char* ta = lds + (hf == 0 ? PL_TK : PL_TR) + hd * PLH; const LAS unsigned char* tb = lds + PL_TB + hd * PLH; const LAS unsigned char* tq = lds + PL_TQ + hd * PLH;
          f32x4 pb_ = (f32x4){0.f, 0.f, 0.f, 0.f}, pq_ = (f32x4){0.f, 0.f, 0.f, 0.f};
#pragma unroll
          for (int s = 0; s < 2; ++s) { const bf16x8 af = *(const LAS bf16x8*)(ta + c16 * PLP + (32 * s + 8 * g) * 2), bf_ = *(const LAS bf16x8*)(tb + c16 * PLP + (32 * s + 8 * g) * 2), qf_ = *(const LAS bf16x8*)(tq + c16 * PLP + (32 * s + 8 * g) * 2);
              pb_ = __builtin_amdgcn_mfma_f32_16x16x32_bf16(af, bf_, pb_, 0, 0, 0); pq_ = __builtin_amdgcn_mfma_f32_16x16x32_bf16(af, qf_, pq_, 0, 0, 0); }
          LAS float* A1 = (LAS float*)(lds + PL_A1) + hd * 256;
          if (hf == 0) {
#pragma unroll
              for (int j = 0; j < 4; ++j) { const int t = 4 * g + j; const bool lo_ = c16 < t; A1[t * 16 + c16] = lo_ ? pb_[j] : 0.f; *(GAS bf16*)(rech + RC_A2 + t * RC_P16 + c16 * 2) = (bf16)f2bf(lo_ ? pq_[j] : 0.f); }
              asm volatile("s_waitcnt lgkmcnt(0)" ::: "memory");
              float Mc[16];
#pragma unroll
              for (int t = 0; t < 16; ++t) { float mval = (t == c16) ? 1.f : 0.f;
#pragma unroll
                  for (int i = 0; i < 16; ++i) if (i < t) mval -= A1[t * 16 + i] * Mc[i];
                  Mc[t] = mval; }
              if (lane < 16) {
#pragma unroll
                  for (int t = 0; t < 16; ++t) *(GAS bf16*)(rech + RC_MM + t * RC_P16 + c16 * 2) = (bf16)f2bf(Mc[t]); }
          } else {
#pragma unroll
              for (int j = 0; j < 4; ++j) { const int t = 4 * g + j; const bool le_ = c16 <= t; *(GAS bf16*)(rech + RC_A34 + t * RC_P32 + c16 * 2) = (bf16)f2bf(le_ ? pq_[j] : 0.f); *(GAS bf16*)(rech + RC_A34 + t * RC_P32 + 32 + c16 * 2) = (bf16)f2bf(le_ ? -pb_[j] : 0.f); }
          } }
    }
}
__device__ __forceinline__ void rwkv_chunk_item(GAS unsigned char* ws, LAS unsigned char* lds, int bh, int tid) {
    const int lane = tid & 63, w = __builtin_amdgcn_readfirstlane(tid >> 6), g = lane >> 4, c16 = lane & 15; const int h = bh & 3, b = bh >> 2;
    const GAS unsigned char* recs = ws + WS_RREC + (size_t)bh * (SEQ / 16) * RC_SIZE; GAS float* yraw = (GAS float*)(ws + WS_YRAW) + ((size_t)b * SEQ) * 256 + h * 64 + 16 * w + c16;
    const bool has2 = (tid + 512) * 16 < RC_USED;
    v4u r0, r1;
    __syncthreads();
    r0 = *(const GAS v4u*)(recs + tid * 16); if (has2) r1 = *(const GAS v4u*)(recs + (tid + 512) * 16);
    *(LAS v4u*)(lds + tid * 16) = r0; if (has2) *(LAS v4u*)(lds + (tid + 512) * 16) = r1;
    __syncthreads();
    f32x4 X[4] = {(f32x4){0.f, 0.f, 0.f, 0.f}, (f32x4){0.f, 0.f, 0.f, 0.f}, (f32x4){0.f, 0.f, 0.f, 0.f}, (f32x4){0.f, 0.f, 0.f, 0.f}};
    for (int c = 0; c < SEQ / 16; ++c) {
        const int cur = c & 1; const bool more = c + 1 < SEQ / 16;
        if (more) { const GAS unsigned char* rn = recs + (size_t)(c + 1) * RC_SIZE; r0 = *(const GAS v4u*)(rn + tid * 16); if (has2) r1 = *(const GAS v4u*)(rn + (tid + 512) * 16); }
        if (w < 4) {
            const LAS unsigned char* R = lds + cur * RC_SIZE;
            typedef unsigned long long u64;
#define LD8(off) (*(const LAS v2u*)(R + (off)))
#define MK8(lo_, hi_) __builtin_bit_cast(bf16x8, (v4u){(lo_).x, (lo_).y, (hi_).x, (hi_).y})
            const v2u z2 = (v2u){0u, 0u};
            bf16x8 xb[2];
#pragma unroll
            for (int s = 0; s < 2; ++s) { v4u t_; t_.x = cvtpk(X[2 * s][0], X[2 * s][1]); t_.y = cvtpk(X[2 * s][2], X[2 * s][3]); t_.z = cvtpk(X[2 * s + 1][0], X[2 * s + 1][1]); t_.w = cvtpk(X[2 * s + 1][2], X[2 * s + 1][3]); xb[s] = __builtin_bit_cast(bf16x8, t_); }
            f32x4 U = (f32x4){0.f, 0.f, 0.f, 0.f}, Y = (f32x4){0.f, 0.f, 0.f, 0.f};
#pragma unroll
            for (int s = 0; s < 2; ++s) { const bf16x8 kt = MK8(LD8(RC_KT + c16 * RC_P64 + (32 * s + 4 * g) * 2), LD8(RC_KT + c16 * RC_P64 + (32 * s + 16 + 4 * g) * 2));
                const bf16x8 rt = MK8(LD8(RC_RT + c16 * RC_P64 + (32 * s + 4 * g) * 2), LD8(RC_RT + c16 * RC_P64 + (32 * s + 16 + 4 * g) * 2));
                U = __builtin_amdgcn_mfma_f32_16x16x32_bf16(kt, xb[s], U, 0, 0, 0); Y = __builtin_amdgcn_mfma_f32_16x16x32_bf16(rt, xb[s], Y, 0, 0, 0); }
            const v2u vf4 = LD8(RC_VT + (16 * w + c16) * RC_P16 + (4 * g) * 2);
            { const bf16x8 a2f = MK8(LD8(RC_A2 + c16 * RC_P16 + (4 * g) * 2), z2); U = __builtin_amdgcn_mfma_f32_16x16x32_bf16(a2f, MK8(vf4, z2), U, 0, 0, 0); }
            f32x4 Z = (f32x4){0.f, 0.f, 0.f, 0.f};
            { const bf16x8 mf = MK8(LD8(RC_MM + c16 * RC_P16 + (4 * g) * 2), z2); v2u wb; wb.x = cvtpk(U[0], U[1]); wb.y = cvtpk(U[2], U[3]); Z = __builtin_amdgcn_mfma_f32_16x16x32_bf16(mf, MK8(wb, z2), Z, 0, 0, 0); }
            v2u zb; zb.x = cvtpk(Z[0], Z[1]); zb.y = cvtpk(Z[2], Z[3]);
            const bf16x8 vz = MK8(vf4, zb);
            { const bf16x8 a34 = MK8(LD8(RC_A34 + c16 * RC_P32 + (4 * g) * 2), LD8(RC_A34 + c16 * RC_P32 + (16 + 4 * g) * 2)); Y = __builtin_amdgcn_mfma_f32_16x16x32_bf16(a34, vz, Y, 0, 0, 0); }
#pragma unroll
            for (int et = 0; et < 4; ++et) { const f32x4 gm = *(const LAS f32x4*)(R + RC_GM + (16 * et + 4 * g) * 4);
                const bf16x8 kb = MK8(LD8(RC_KB + (16 * et + c16) * RC_P32 + (4 * g) * 2), LD8(RC_KB + (16 * et + c16) * RC_P32 + (16 + 4 * g) * 2));
                X[et] = __builtin_amdgcn_mfma_f32_16x16x32_bf16(kb, vz, X[et] * gm, 0, 0, 0); }
#pragma unroll
            for (int j = 0; j < 4; ++j) yraw[(size_t)(c * 16 + 4 * g + j) * 256] = Y[j];
#undef LD8
#undef MK8
        }
        if (more) { LAS unsigned char* Wn = lds + (cur ^ 1) * RC_SIZE; *(LAS v4u*)(Wn + tid * 16) = r0; if (has2) *(LAS v4u*)(Wn + (tid + 512) * 16) = r1; }
        __syncthreads();
    }
}

__device__ __forceinline__ void phase_mix(const KIn ain, GAS unsigned char* ws, int l, const GAS bf16* proj, GAS bf16* ybuf, LAS unsigned char* lds, int bid, int nb, int tid0) {
    for (int it = bid; it < 64 + 256; it += nb) {
        int tid = tid0; asm volatile("" : "+v"(tid));
        if (it < 32) { rwkv_chunk_item(ws, lds, it, tid); continue; }
        if (it < 64) { mlstm_item(ain, ws, l, proj, ybuf, lds, it - 32, tid); continue; }
        const int j = it - 64; fox_mfma_item(ws, proj, ybuf, lds, j & 31, 7 - (j >> 5), tid);
    }
}
__device__ __forceinline__ void phase_rwkv_post(const KIn ain, GAS unsigned char* ws, int l, const GAS bf16* proj, GAS bf16* ybuf, int gw, int ngw, int lane) {
    const GAS float* yraw = (const GAS float*)(ws + WS_YRAW); const GAS float* sbon = (const GAS float*)(ws + WS_SBON);
    const f32x4 gg = ((const GAS f32x4*)(ain[18] + l * 256))[lane], gb = ((const GAS f32x4*)(ain[19] + l * 256))[lane], muv = ((const GAS f32x4*)(ain[10] + l * 896 + 512))[lane];
    for (int m = gw; m < MTOK; m += ngw) {
        const f32x4 y = ((const GAS f32x4*)(yraw + (size_t)m * 256))[lane];
        const float mean = grp16_sum((y.x + y.y) + (y.z + y.w)) * (1.f / 64.f);
        const f32x4 dlt = y - mean; const float var = grp16_sum((dlt.x * dlt.x + dlt.y * dlt.y) + (dlt.z * dlt.z + dlt.w * dlt.w)) * (1.f / 64.f);
        const float rs = 1.f / sqrtf(var + GN_EPS); const float sb = sbon[(size_t)m * 4 + (lane >> 4)];
        const v2u cw = *(const GAS v2u*)(proj + (size_t)m * PP + P_CV + lane * 4); v2u pw = (v2u){0u, 0u}; if ((m & (SEQ - 1)) > 0) pw = *(const GAS v2u*)(proj + (size_t)(m - 1) * PP + P_CV + lane * 4);
        const v2u zw = *(const GAS v2u*)(proj + (size_t)m * PP + P_CZ + lane * 4);
        const float c0 = bflo(cw.x), c1 = bfhi(cw.x), c2 = bflo(cw.y), c3 = bfhi(cw.y);
        const float v0 = c0 + muv.x * (bflo(pw.x) - c0), v1 = c1 + muv.y * (bfhi(pw.x) - c1), v2 = c2 + muv.z * (bflo(pw.y) - c2), v3 = c3 + muv.w * (bfhi(pw.y) - c3);
        const float o0 = (dlt.x * rs * gg.x + gb.x + sb * v0) * silu_f(bflo(zw.x)), o1 = (dlt.y * rs * gg.y + gb.y + sb * v1) * silu_f(bfhi(zw.x));
        const float o2 = (dlt.z * rs * gg.z + gb.z + sb * v2) * silu_f(bflo(zw.y)), o3 = (dlt.w * rs * gg.w + gb.w + sb * v3) * silu_f(bfhi(zw.y));
        v2u o; o.x = pk2(o0, o1); o.y = pk2(o2, o3); *(GAS v2u*)(ybuf + (size_t)m * DM + 512 + lane * 4) = o;
    }
}
constexpr int XROW = 672;
__device__ __forceinline__ void xattn_mfma(GAS unsigned char* ws, const GAS bf16* qbuf, GAS bf16* obuf, LAS unsigned char* lds, int bid, int nb, int tid) {
    const GAS bf16* kv = (const GAS bf16*)(ws + WS_KV);
    const int lane = tid & 63, w = __builtin_amdgcn_readfirstlane(tid >> 6), g = lane >> 4, c16 = lane & 15;
    LAS unsigned char* Kb = lds; LAS unsigned char* Vb = lds + 2 * 32 * XROW;
    const int sr = tid >> 4, sc8 = (tid & 15) * 8;
    for (int it = bid; it < 512; it += nb) {
        const int qb = it & 15, h = (it >> 4) & 3, b = it >> 6; const size_t mq = (size_t)b * SEQ + qb * 128 + 16 * w + c16;
        const GAS bf16* kvb = kv + (size_t)b * NMEM * 2048 + h * 256;
        bf16x8 qf[8];
#pragma unroll
        for (int s = 0; s < 8; ++s) qf[s] = *(const GAS bf16x8*)(qbuf + mq * DM + h * 256 + 32 * s + 8 * g);
        f32x4 o[16];
#pragma unroll
        for (int n = 0; n < 16; ++n) o[n] = (f32x4){0.f, 0.f, 0.f, 0.f};
        float mx = -1e30f, ls = 0.f;
        __syncthreads();
        { const GAS bf16* rowp = kvb + (size_t)sr * 2048 + sc8;
          *(LAS v4u*)(Kb + sr * XROW + sc8 * 2) = *(const GAS v4u*)(rowp); *(LAS v4u*)(Kb + sr * XROW + (sc8 + 128) * 2) = *(const GAS v4u*)(rowp + 128);
          *(LAS v4u*)(Vb + sr * XROW + sc8 * 2) = *(const GAS v4u*)(rowp + 1024); *(LAS v4u*)(Vb + sr * XROW + (sc8 + 128) * 2) = *(const GAS v4u*)(rowp + 1024 + 128); }
        __syncthreads();
        for (int kt = 0; kt < 8; ++kt) {
            const int cur = kt & 1; const bool more = kt + 1 < 8;
            v4u k0r, k1r, v0r, v1r;
            if (more) { const GAS bf16* rowp = kvb + (size_t)(32 * (kt + 1) + sr) * 2048 + sc8; k0r = *(const GAS v4u*)(rowp); k1r = *(const GAS v4u*)(rowp + 128); v0r = *(const GAS v4u*)(rowp + 1024); v1r = *(const GAS v4u*)(rowp + 1024 + 128); }
            const LAS unsigned char* Kc = Kb + cur * 32 * XROW; const LAS unsigned char* Vc = Vb + cur * 32 * XROW;
            f32x4 sacc[2];
#pragma unroll
            for (int n = 0; n < 2; ++n) { sacc[n] = (f32x4){0.f, 0.f, 0.f, 0.f};
#pragma unroll
                for (int s = 0; s < 8; ++s) { const bf16x8 kf = *(const LAS bf16x8*)(Kc + (16 * n + c16) * XROW + (32 * s + 8 * g) * 2);
                    sacc[n] = __builtin_amdgcn_mfma_f32_16x16x32_bf16(kf, qf[s], sacc[n], 0, 0, 0); } }
            float rm = -1e30f;
#pragma unroll
            for (int n = 0; n < 2; ++n)
#pragma unroll
                for (int j = 0; j < 4; ++j) { const float sc = sacc[n][j] * 0.0625f; sacc[n][j] = sc; rm = fmaxf(rm, sc); }
            rm = fmaxf(rm, __shfl_xor(rm, 16)); rm = fmaxf(rm, __shfl_xor(rm, 32));
            const float mnew = fmaxf(mx, rm); const float alpha = __expf(mx - mnew); mx = mnew;
            float psum = 0.f;
#pragma unroll
            for (int n = 0; n < 2; ++n)
#pragma unroll
                for (int j = 0; j < 4; ++j) { const float p = __expf(sacc[n][j] - mnew); sacc[n][j] = p; psum += p; }
            ls = ls * alpha + psum;
#pragma unroll
            for (int n = 0; n < 16; ++n) o[n] = o[n] * alpha;
            v4u pw; pw.x = cvtpk(sacc[0][0], sacc[0][1]); pw.y = cvtpk(sacc[0][2], sacc[0][3]); pw.z = cvtpk(sacc[1][0], sacc[1][1]); pw.w = cvtpk(sacc[1][2], sacc[1][3]);
            const bf16x8 pf = __builtin_bit_cast(bf16x8, pw);
            const int tq4 = c16 >> 2, tp = c16 & 3;
#pragma unroll
            for (int n = 0; n < 16; ++n) { const LAS unsigned char* a1 = Vc + (4 * g + tq4) * XROW + (16 * n + 4 * tp) * 2;
                const s16x4 lo = ds_tr16(a1), hi = ds_tr16(a1 + 16 * XROW);
                const bf16x8 vf = (bf16x8){lo[0], lo[1], lo[2], lo[3], hi[0], hi[1], hi[2], hi[3]};
                o[n] = __builtin_amdgcn_mfma_f32_16x16x32_bf16(vf, pf, o[n], 0, 0, 0); }
            if (more) { const int nx = cur ^ 1; LAS unsigned char* kd = Kb + nx * 32 * XROW + sr * XROW + sc8 * 2; LAS unsigned char* vd = Vb + nx * 32 * XROW + sr * XROW + sc8 * 2;
                *(LAS v4u*)kd = k0r; *(LAS v4u*)(kd + 256) = k1r; *(LAS v4u*)vd = v0r; *(LAS v4u*)(vd + 256) = v1r; }
            __syncthreads();
        }
        float l = ls; l += __shfl_xor(l, 16); l += __shfl_xor(l, 32); const float inv = 1.f / l;
        GAS bf16* orow = obuf + mq * DM + h * 256 + 4 * g;
#pragma unroll
        for (int n = 0; n < 16; ++n) { v2u ow; ow.x = pk2(o[n][0] * inv, o[n][1] * inv); ow.y = pk2(o[n][2] * inv, o[n][3] * inv); *(GAS v2u*)(orow + 16 * n) = ow; }
    }
}

#endif
constexpr int PH_PER_LAYER = 12, N_PHASES = 1 + DEPTH * PH_PER_LAYER;
__global__ void __launch_bounds__(NTHR, 2) mk_fwd(Args args) {
#if defined(__HIP_DEVICE_COMPILE__)
    extern __shared__ __attribute__((aligned(16))) unsigned char lds_raw[];
    LAS unsigned char* lds = (LAS unsigned char*)lds_raw;
    unsigned char* ws0 = args.ws;
    volatile LAS unsigned* MISC = (volatile LAS unsigned*)(lds + MISC_OFF);
    for (int u = threadIdx.x; u < (LDS_BYTES - LDSCTL_OFF) / 4; u += NTHR) ((LAS unsigned*)(lds + LDSCTL_OFF))[u] = 0u;
    __syncthreads();
    XcdBarrier bar; bar.bar = (GAS unsigned*)(ws0 + WS_CTL) + CW_BAR; bar.x = 0; bar.st = nullptr;
    const bool multi = (args.ph_hi - args.ph_lo) > 1;
    if (multi && !args.use_cg) bar = xcd_barrier_post((GAS unsigned*)(ws0 + WS_CTL) + CW_BAR, MISC + 8);
    GAS float* xout = (GAS float*)args.out;
    bool dup_done = false; (void)dup_done;
    for (int ph = args.ph_lo; ph < args.ph_hi; ++ph) {
        int tid = threadIdx.x; asm volatile("" : "+v"(tid));
        int bid = blockIdx.x, G = gridDim.x; unsigned char* wsl = ws0; asm volatile("" : "+s"(bid), "+s"(G), "+s"(wsl)); GAS unsigned char* ws = (GAS unsigned char*)wsl;
        KIn ain; ain.kp = (const CAS unsigned char*)__builtin_amdgcn_kernarg_segment_ptr(); asm volatile("" : "+s"(ain.kp));
        const int lane = tid & 63, wave = __builtin_amdgcn_readfirstlane(tid >> 6); const int gw = bid * NWAVES + wave, ngw = G * NWAVES;
        GAS bf16* bufA = (GAS bf16*)(ws + WS_BUFA); GAS bf16* proj = (GAS bf16*)(ws + WS_BUFP); GAS float* ytmp = (GAS float*)(ws + WS_BUFP); GAS bf16* qbuf = (GAS bf16*)(ws + WS_BUFP + 64 * MiB);
        if (ph == 0) {
            rows_norm_bf16(ain[0], bufA, MTOK, gw, ngw, lane);
            rows_norm_bf16(ain[1], (GAS bf16*)(ws + WS_MEMN), MMEM, gw, ngw, lane);
        } else {
            const int l = (ph - 1) / PH_PER_LAYER, s = (ph - 1) % PH_PER_LAYER;
#ifndef PHMASK
#define PHMASK 0xFFF
#endif
            switch (s) {
            case 0: if (!((PHMASK >> 0) & 1)) break; phase_convert(ain, ws, l, lds, gw, ngw, wave, lane); break;
            case 1: if (!((PHMASK >> 1) & 1)) break; { pg8::Gemm g{(const GAS bf16*)(ws + WS_MEMN), (const GAS bf16*)(ws + WS_WKV), MMEM, 2 * DM, DM}; pg8::StaticOrder S; S.init(MMEM, 2 * DM, G, bid);
                      pg8::EpiB16 E{(GAS bf16*)(ws + WS_KV), 2 * DM}; pg8::gemm_phase<pg8::EpiB16, pg8::StaticOrder, true, true>(lds, g, S, E); } break;
            case 2: if (!((PHMASK >> 2) & 1)) break; { pg8::Gemm g{bufA, (const GAS bf16*)(ws + WS_WIN), MTOK, NINP, DM}; pg8::StaticOrder S; S.init(MTOK, NINP, G, bid);
                      pg8::EpiProj E{proj, PP, PP, (const GAS float*)(ws + WS_BIASP), (GAS float*)(ws + WS_GATES), P_G, MTOK}; pg8::gemm_phase<pg8::EpiProj, pg8::StaticOrder, true, true>(lds, g, S, E); } break;
            case 3: if (!((PHMASK >> 3) & 1)) break; prep_cumsum((const GAS float*)(ws + WS_GATES), (GAS float*)(ws + WS_CUM), gw, ngw, lane);
                    prep_foxnorm(proj, ain[20] + l * 128, gw, ngw, lane);
                    prep_rwkv(ain, ws, l, proj, lds, bid, G, tid);
                    prep_pool(ain, ws, l, proj, bufA, lds, bid, G, tid); break;
            case 4: if (!((PHMASK >> 4) & 1)) break; phase_mix(ain, ws, l, proj, bufA, lds, bid, G, tid); break;
            case 5: if (!((PHMASK >> 5) & 1)) break; phase_rwkv_post(ain, ws, l, proj, bufA, gw, ngw, lane); break;
            case 6: if (!((PHMASK >> 6) & 1)) break; { pg8::Gemm g{bufA, (const GAS bf16*)(ws + WS_WOUT), MTOK, DM, DM}; pg8::StaticOrder S; S.init(MTOK, DM, G, bid);
                      pg8::EpiF32 E{ytmp, DM}; pg8::gemm_phase<pg8::EpiF32, pg8::StaticOrder, true, true>(lds, g, S, E); } break;
            case 7: if (!((PHMASK >> 7) & 1)) break; rows_residual(ytmp, l == 0 ? ain[0] : xout, xout, bufA, ain[3] + l * DM, gw, ngw, lane); break;
            case 8: if (!((PHMASK >> 8) & 1)) break; { pg8::Gemm g{bufA, (const GAS bf16*)(ws + WS_WQ), MTOK, DM, DM}; pg8::StaticOrder S; S.init(MTOK, DM, G, bid);
                      pg8::EpiB16 E{qbuf, DM}; pg8::gemm_phase<pg8::EpiB16, pg8::StaticOrder, true, true>(lds, g, S, E); } break;
            case 9: if (!((PHMASK >> 9) & 1)) break; xattn_mfma(ws, qbuf, bufA, lds, bid, G, tid); break;
            case 10: if (!((PHMASK >> 10) & 1)) break; { pg8::Gemm g{bufA, (const GAS bf16*)(ws + WS_WO), MTOK, DM, DM}; pg8::StaticOrder S; S.init(MTOK, DM, G, bid);
                       pg8::EpiF32 E{ytmp, DM}; pg8::gemm_phase<pg8::EpiF32, pg8::StaticOrder, true, true>(lds, g, S, E); } break;
            case 11: if (!((PHMASK >> 11) & 1)) break; rows_residual(ytmp, xout, xout, bufA, ain[24] + l * DM, gw, ngw, lane); break;
            }
        }
#ifdef PHDUP
        if (ph > 0 && ((PHDUP >> ((ph - 1) % PH_PER_LAYER)) & 1) && !dup_done) { dup_done = true; xcd_barrier(bar); --ph; continue; }
        dup_done = false;
#endif
        if (ph + 1 < args.ph_hi) { if (args.use_cg) { cg::this_grid().sync(); } else { xcd_barrier(bar); } }
    }
#endif
}

#ifndef MK_SPLIT
#define MK_SPLIT 0
#endif
extern "C" void kernel_launch(void* const* d_in, const int* in_sizes, int n_in, void* d_out, int out_size, void* d_ws, size_t ws_size, hipStream_t stream) {
    static int grid = 0;
    if (grid == 0) {
        if (n_in != 28 || out_size != MTOK * DM || ws_size < WS_END) { fprintf(stderr, "kernel_launch: unexpected shapes (n_in %d out %d ws %zu)\n", n_in, out_size, ws_size); grid = -1; return; }
        int dev = 0, cus = 0, per_cu = 0;
        hipGetDevice(&dev); hipDeviceGetAttribute(&cus, hipDeviceAttributeMultiprocessorCount, dev);
        hipFuncSetAttribute((const void*)mk_fwd, hipFuncAttributeMaxDynamicSharedMemorySize, LDS_BYTES);
        hipOccupancyMaxActiveBlocksPerMultiprocessor(&per_cu, (const void*)mk_fwd, NTHR, LDS_BYTES);
        (void)hipGetLastError();
        if (per_cu < 1) { fprintf(stderr, "kernel_launch: occupancy query says %d blocks/CU\n", per_cu); }
        grid = cus;
    }
    if (grid < 0) return;
    hipMemsetAsync((char*)d_ws + WS_CTL, 0, CTL_ZERO_BYTES, stream);
    Args a{};
    for (int i = 0; i < 28; ++i) a.in[i] = (const float*)d_in[i];
    a.out = (float*)d_out; a.ws = (unsigned char*)d_ws; a.use_cg = 0; a.pad = 0;
#if MK_SPLIT
    for (int ph = 0; ph < N_PHASES; ++ph) { a.ph_lo = ph; a.ph_hi = ph + 1; hipLaunchKernelGGL(mk_fwd, dim3(grid), dim3(NTHR), LDS_BYTES, stream, a); }
#else
    a.ph_lo = 0; a.ph_hi = N_PHASES;
    void* kargs[] = {&a};
    hipError_t e = hipLaunchCooperativeKernel((const void*)mk_fwd, dim3(grid), dim3(NTHR), kargs, LDS_BYTES, stream);
    if (e != hipSuccess) fprintf(stderr, "cooperative launch failed: %s (grid %d)\n", hipGetErrorString(e), grid);
#endif
}
```
